# Optimizing an MI355X kernel written in HIP

```python
import jax, jax.numpy as jnp
from jax import lax
import numpy as np

D_MODEL = 1024
BATCH = 8
SEQ = 8192
DEPTH = 2

CTX_LEN = 256
GRID_W = 64
W_BRANCH = 512
N_BRANCH = 3
CHUNK = 128
A_GROUPS = 4
A_GW = W_BRANCH // A_GROUPS
B_BLOCKS = 8
B_BW = W_BRANCH // B_BLOCKS
CONV_W = 4
CONV_PAD_L = 2
LRU_C = 8.0
C_HEADS = 8
C_HD = W_BRANCH // C_HEADS
WIN_R = 8
WIN_C = 16
ROPE_BASE = 10000.0
IN_SPLITS = (W_BRANCH,) * 9 + (N_BRANCH * D_MODEL,)
N_IN = 9 * W_BRANCH + N_BRANCH * D_MODEL
ALPHA = (2 * DEPTH) ** 0.25
BETA = (8 * DEPTH) ** -0.25
LN_EPS = 1e-5

kernel_name = "hybrid_gmlp_rglru_natten_deepnorm"


def layer_norm(x, g, b):
    xf = x.astype(jnp.float32)
    mu = jnp.mean(xf, -1, keepdims=True)
    var = jnp.mean(jnp.square(xf - mu), -1, keepdims=True)
    y = (xf - mu) * lax.rsqrt(var + LN_EPS) * g.astype(jnp.float32) + b.astype(jnp.float32)
    return y.astype(x.dtype)


def split_cols(z):
    idx = [int(i) for i in np.cumsum(IN_SPLITS)[:-1]]
    return jnp.split(z, idx, axis=-1)


def heads(z):
    return z.reshape(*z.shape[:-1], C_HEADS, C_HD)


def chunk_sgu(u, v, ln_g, ln_b, w_s, b_s):
    bsz, L, _ = v.shape
    v = layer_norm(v, ln_g, ln_b).reshape(bsz, L // CHUNK, CHUNK, A_GROUPS, A_GW)
    v = jnp.einsum("gpq,bnqgc->bnpgc", w_s, v) + b_s.T[:, :, None]
    return u * v.reshape(bsz, L, W_BRANCH)


def depthwise_conv_centred(x, w, b):
    L = x.shape[1]
    xp = jnp.pad(x, ((0, 0), (CONV_PAD_L, CONV_W - 1 - CONV_PAD_L), (0, 0)))
    return b + sum(xp[:, j:j + L] * w[j] for j in range(CONV_W))


def rglru_coeffs(x, wa, ba, wx, bx, lam):
    bsz, L, _ = x.shape
    xb = x.reshape(bsz, L, B_BLOCKS, B_BW)
    r = jax.nn.sigmoid(jnp.einsum("blhi,hij->blhj", xb, wa).reshape(bsz, L, W_BRANCH) + ba)
    i = jax.nn.sigmoid(jnp.einsum("blhi,hij->blhj", xb, wx).reshape(bsz, L, W_BRANCH) + bx)
    log_a = -LRU_C * r.astype(jnp.float32) * jax.nn.softplus(-lam.astype(jnp.float32))
    a = jnp.exp(log_a)
    b = jnp.sqrt(-jnp.expm1(2.0 * log_a)) * (i * x).astype(jnp.float32)
    return a, b


def linear_scan(a, b, h0, reverse):
    idx = -1 if reverse else 0
    b = b.at[:, idx].add(a[:, idx] * h0)

    def combine(left, right):
        al, bl = left
        ar, br = right
        return ar * al, ar * bl + br

    _, h = lax.associative_scan(combine, (a, b), reverse=reverse, axis=1)
    return h


def rglru_bidir(x_lat, x_ctx, conv_w, conv_b, wa, ba, wx, bx, lam, with_ctx):
    xl = depthwise_conv_centred(x_lat, conv_w, conv_b)
    xc = depthwise_conv_centred(x_ctx, conv_w, conv_b)
    h0 = jnp.zeros((x_lat.shape[0], W_BRANCH), jnp.float32)
    ys_lat, ys_ctx = [], []
    for d, rev in enumerate((False, True)):
        a_c, b_c = rglru_coeffs(xc, wa[d], ba[d], wx[d], bx[d], lam[d])
        h_c = linear_scan(a_c, b_c, h0, rev)
        h_fin = h_c[:, 0] if rev else h_c[:, -1]
        a_l, b_l = rglru_coeffs(xl, wa[d], ba[d], wx[d], bx[d], lam[d])
        ys_lat.append(linear_scan(a_l, b_l, h_fin, rev))
        if with_ctx:
            ys_ctx.append(h_c)
    y_lat = (ys_lat[0] + ys_lat[1]).astype(x_lat.dtype)
    y_ctx = (ys_ctx[0] + ys_ctx[1]).astype(x_ctx.dtype) if with_ctx else None
    return y_lat, y_ctx


def rope_2d(x, rows, cols):
    half = C_HD // 2
    quarter = half // 2
    inv_freq = ROPE_BASE ** (-jnp.arange(quarter, dtype=jnp.float32) / quarter)

    def rotate(xa, p):
        ang = p.astype(jnp.float32)[:, None] * inv_freq
        cos = jnp.cos(ang)[None, :, None, :]
        sin = jnp.sin(ang)[None, :, None, :]
        xa = xa.astype(jnp.float32)
        x1, x2 = xa[..., :quarter], xa[..., quarter:]
        return jnp.concatenate([x1 * cos - x2 * sin, x1 * sin + x2 * cos], -1)

    out = jnp.concatenate([rotate(x[..., :half], rows), rotate(x[..., half:], cols)], -1)
    return out.astype(x.dtype)


def neighbourhood_attention(q, k, v, k_ctx, v_ctx, rpb):
    bsz, L, nh, hd = q.shape
    rows = L // GRID_W
    wr = min(WIN_R, rows)
    scale = hd ** -0.5
    qg = q.reshape(bsz, rows, GRID_W, nh, hd)
    kg = k.reshape(bsz, rows, GRID_W, nh, hd)
    vg = v.reshape(bsz, rows, GRID_W, nh, hd)
    qc = jnp.arange(GRID_W)
    c0 = jnp.clip(qc - WIN_C // 2, 0, GRID_W - WIN_C)
    col_idx = c0[:, None] + jnp.arange(WIN_C)[None, :]
    col_bias_idx = col_idx - qc[:, None] + (WIN_C - 1)

    def row_block(r):
        r0 = jnp.clip(r - wr // 2, 0, rows - wr)
        k_rows = lax.dynamic_slice_in_dim(kg, r0, wr, axis=1)
        v_rows = lax.dynamic_slice_in_dim(vg, r0, wr, axis=1)
        k_win = k_rows[:, :, col_idx]
        v_win = v_rows[:, :, col_idx]
        q_r = lax.dynamic_index_in_dim(qg, r, axis=1, keepdims=False)
        s_loc = jnp.einsum("bqhd,bsqchd->bhqsc", q_r, k_win).astype(jnp.float32) * scale
        row_off = r0 + jnp.arange(wr) - r + (WIN_R - 1)
        bias = rpb[:, row_off[None, :, None], col_bias_idx[:, None, :]]
        s_loc = s_loc + bias[None].astype(jnp.float32)
        s_ctx = jnp.einsum("bqhd,bkhd->bhqk", q_r, k_ctx).astype(jnp.float32) * scale
        s = jnp.concatenate([s_loc.reshape(bsz, nh, GRID_W, wr * WIN_C), s_ctx], -1)
        p = jax.nn.softmax(s, -1).astype(v.dtype)
        p_loc = p[..., :wr * WIN_C].reshape(bsz, nh, GRID_W, wr, WIN_C)
        p_ctx = p[..., wr * WIN_C:]
        return (jnp.einsum("bhqsc,bsqchd->bqhd", p_loc, v_win)
                + jnp.einsum("bhqk,bkhd->bqhd", p_ctx, v_ctx))

    out = lax.map(row_block, jnp.arange(rows))
    return out.transpose(1, 0, 2, 3, 4).reshape(bsz, L, nh * hd)


def context_attention(q, k, v):
    s = jnp.einsum("bqhd,bkhd->bhqk", q, k).astype(jnp.float32) * C_HD ** -0.5
    p = jax.nn.softmax(s, -1).astype(v.dtype)
    o = jnp.einsum("bhqk,bkhd->bqhd", p, v)
    return o.reshape(*o.shape[:2], W_BRANCH)


def merge_project(x, ys, g_m, gate, w_br, w_out, ln_g, ln_b):
    g = jax.nn.sigmoid(g_m)
    m = sum(g[..., n * D_MODEL:(n + 1) * D_MODEL] * (ys[n] @ w_br[n]) for n in range(N_BRANCH))
    return layer_norm(ALPHA * x + gate * (m @ w_out), ln_g, ln_b)


def setup_inputs(seed: int = 0) -> dict:
    key = jax.random.key(seed)
    ks = jax.random.split(key, 32)
    f32 = jnp.float32
    nrm = lambda k, shape, s: (jax.random.normal(k, shape, f32) * s).astype(f32)
    a0 = jax.random.uniform(ks[20], (DEPTH, 2, W_BRANCH), f32, minval=0.9, maxval=0.999)
    a_base = a0 ** (1.0 / LRU_C)
    lam = jnp.log(a_base) - jnp.log1p(-a_base)
    return {
        "x": nrm(ks[0], (BATCH, SEQ, D_MODEL), 1.0),
        "c": nrm(ks[1], (BATCH, D_MODEL), 1.0),
        "ctx": nrm(ks[2], (BATCH, CTX_LEN, D_MODEL), 1.0),
        "c_ctx": nrm(ks[3], (D_MODEL,), 1.0),
        "w_ada": nrm(ks[4], (DEPTH, D_MODEL, 3 * D_MODEL), 0.3 * D_MODEL ** -0.5),
        "b_ada": nrm(ks[5], (DEPTH, 3 * D_MODEL), 0.02),
        "w_in": nrm(ks[6], (DEPTH, D_MODEL, N_IN), D_MODEL ** -0.5),
        "b_in": nrm(ks[7], (DEPTH, N_IN), 0.02),
        "sgu_ln_g": 1.0 + nrm(ks[8], (DEPTH, W_BRANCH), 0.02),
        "sgu_ln_b": nrm(ks[9], (DEPTH, W_BRANCH), 0.02),
        "w_s": nrm(ks[10], (DEPTH, A_GROUPS, CHUNK, CHUNK), CHUNK ** -0.5),
        "b_s": 1.0 + nrm(ks[11], (DEPTH, A_GROUPS, CHUNK), 0.1),
        "conv_w": nrm(ks[12], (DEPTH, CONV_W, W_BRANCH), CONV_W ** -0.5),
        "conv_b": nrm(ks[13], (DEPTH, W_BRANCH), 0.02),
        "lru_wa": nrm(ks[14], (DEPTH, 2, B_BLOCKS, B_BW, B_BW), B_BW ** -0.5),
        "lru_ba": nrm(ks[15], (DEPTH, 2, W_BRANCH), 0.02),
        "lru_wx": nrm(ks[16], (DEPTH, 2, B_BLOCKS, B_BW, B_BW), B_BW ** -0.5),
        "lru_bx": nrm(ks[17], (DEPTH, 2, W_BRANCH), 0.02),
        "lru_lam": lam.astype(f32),
        "rpb": nrm(ks[18], (DEPTH, C_HEADS, 2 * WIN_R - 1, 2 * WIN_C - 1), 0.1),
        "w_br": nrm(ks[19], (DEPTH, N_BRANCH, W_BRANCH, D_MODEL), BETA * W_BRANCH ** -0.5),
        "w_out": nrm(ks[21], (DEPTH, D_MODEL, D_MODEL), BETA * D_MODEL ** -0.5),
        "ln_g": 1.0 + nrm(ks[22], (DEPTH, D_MODEL), 0.02),
        "ln_b": nrm(ks[23], (DEPTH, D_MODEL), 0.02),
    }


def reference(x, c, ctx, c_ctx, w_ada, b_ada, w_in, b_in, sgu_ln_g, sgu_ln_b, w_s, b_s,
              conv_w, conv_b, lru_wa, lru_ba, lru_wx, lru_bx, lru_lam, rpb, w_br, w_out,
              ln_g, ln_b):
    L = x.shape[1]
    pos = jnp.arange(L)
    rows_pos, cols_pos = pos // GRID_W, pos % GRID_W
    xc = ctx
    sc = jax.nn.silu(c)
    scc = jax.nn.silu(c_ctx)
    gelu = lambda t: jax.nn.gelu(t, approximate=False)
    for l in range(DEPTH):
        with_ctx = l < DEPTH - 1
        shift, scale, gate = jnp.split(sc @ w_ada[l] + b_ada[l], 3, axis=-1)
        shift_c, scale_c, gate_c = jnp.split(scc @ w_ada[l] + b_ada[l], 3, axis=-1)
        u = x * (1.0 + scale[:, None]) + shift[:, None]
        uc = xc * (1.0 + scale_c) + shift_c
        a_u, a_v, a_g, b_x, b_g, c_q, c_k, c_v, c_g, g_m = split_cols(u @ w_in[l] + b_in[l])
        a_uc, a_vc, a_gc, b_xc, b_gc, c_qc, c_kc, c_vc, c_gc, g_mc = split_cols(uc @ w_in[l] + b_in[l])

        y_a = chunk_sgu(gelu(a_u), gelu(a_v), sgu_ln_g[l], sgu_ln_b[l], w_s[l], b_s[l]) * jax.nn.silu(a_g)
        y_b, y_bc = rglru_bidir(b_x, b_xc, conv_w[l], conv_b[l], lru_wa[l], lru_ba[l],
                                lru_wx[l], lru_bx[l], lru_lam[l], with_ctx)
        y_b = y_b * jax.nn.silu(b_g)
        q = rope_2d(heads(c_q), rows_pos, cols_pos)
        k = rope_2d(heads(c_k), rows_pos, cols_pos)
        k_ctx, v_ctx = heads(c_kc), heads(c_vc)
        y_c = neighbourhood_attention(q, k, heads(c_v), k_ctx, v_ctx, rpb[l]) * jax.nn.silu(c_g)

        x_new = merge_project(x, (y_a, y_b, y_c), g_m, gate[:, None], w_br[l], w_out[l], ln_g[l], ln_b[l])
        if with_ctx:
            y_ac = chunk_sgu(gelu(a_uc), gelu(a_vc), sgu_ln_g[l], sgu_ln_b[l], w_s[l], b_s[l]) * jax.nn.silu(a_gc)
            y_bc = y_bc * jax.nn.silu(b_gc)
            y_cc = context_attention(heads(c_qc), k_ctx, v_ctx) * jax.nn.silu(c_gc)
            xc = merge_project(xc, (y_ac, y_bc, y_cc), g_mc, gate_c, w_br[l], w_out[l], ln_g[l], ln_b[l])
        x = x_new
    return x
```

```cpp
#include <hip/hip_runtime.h>
#include <hip/hip_cooperative_groups.h>
#include <cstdio>
namespace cg = cooperative_groups;


typedef unsigned short u16;
using bf16x8 = __attribute__((ext_vector_type(8))) short;
using f32x16 = __attribute__((ext_vector_type(16))) float;
#define DI __device__ __forceinline__
#define MFMA(a, b, c) __builtin_amdgcn_mfma_f32_32x32x16_bf16((a), (b), (c), 0, 0, 0)

constexpr int T_LAT = 65536;
constexpr int T_CTX = 2048;
constexpr int NTOK = T_LAT + T_CTX;
constexpr int DM = 1024;
constexpr int NIN = 7680;
constexpr int ZC = 4096;
constexpr int NTHREADS = 512;
constexpr int LDS_BYTES = 163840;
constexpr float ALPHA_DN = 1.4142135623730951f;

constexpr size_t OFF_WTIN = 0;
constexpr size_t OFF_WTBR = OFF_WTIN + 2ull * 7680 * 1024 * 2;
constexpr size_t OFF_WTOUT = OFF_WTBR + 2ull * 3 * 1024 * 512 * 2;
constexpr size_t OFF_LRUW = OFF_WTOUT + 2ull * 1024 * 1024 * 2;
constexpr size_t OFF_WSB = OFF_LRUW + 2ull * 2 * 2 * 8 * 4096 * 2;
constexpr size_t OFF_BIASP = OFF_WSB + 2ull * 4 * 128 * 128 * 2;
constexpr size_t OFF_MOD = OFF_BIASP + 65536;
constexpr size_t OFF_ROPE = OFF_MOD + 262144;
constexpr size_t OFF_AGG = OFF_ROPE + 16384;
constexpr size_t AGG_HALF = 528ull * 2 * 512 * 4;
constexpr size_t OFF_U = OFF_AGG + 2 * AGG_HALF;
constexpr size_t OFF_M = OFF_U + (size_t)NTOK * 1024 * 2;
constexpr size_t OFF_Z = OFF_M + (size_t)NTOK * 1024 * 2;
constexpr size_t OFF_VTL = OFF_Z + (size_t)NTOK * ZC * 2;
constexpr size_t OFF_VTC = OFF_VTL + 8ull * 512 * 8192 * 2;
constexpr size_t OFF_GS = OFF_VTC + 8ull * 512 * 256 * 2;
constexpr size_t OFF_RCTX = OFF_GS + 256ull * 256 * 256 * 2;
constexpr size_t OFF_BAR = OFF_RCTX + (size_t)T_CTX * 1024 * 4;
constexpr size_t WS_END = OFF_BAR + 256;

struct Params {
  const float *x, *c, *ctx, *c_ctx, *w_ada, *b_ada, *w_in, *b_in, *sgu_ln_g, *sgu_ln_b, *w_s, *b_s,
      *conv_w, *conv_b, *lru_wa, *lru_ba, *lru_wx, *lru_bx, *lru_lam, *rpb, *w_br, *w_out, *ln_g, *ln_b;
  float* out;
  char* ws;
};

DI unsigned pk2(float a, float b) {
  typedef __bf16 bf2 __attribute__((ext_vector_type(2)));
  typedef float f2 __attribute__((ext_vector_type(2)));
  f2 v = {a, b};
  bf2 r = __builtin_convertvector(v, bf2);
  return __builtin_bit_cast(unsigned, r);
}
DI u16 f2bf(float a) { return (u16)(pk2(a, 0.f) & 0xffffu); }
DI float bflo(unsigned v) { return __uint_as_float(v << 16); }
DI float bfhi(unsigned v) { return __uint_as_float(v & 0xffff0000u); }
DI float bf2f(u16 v) { return __uint_as_float(((unsigned)v) << 16); }
DI int thr() { int t = threadIdx.x; asm volatile("" : "+v"(t)); return t; }
DI int crow(int i, int hh) { return (i & 3) + 8 * (i >> 2) + 4 * hh; }
DI float sigmoidf_(float x) { return __builtin_amdgcn_rcpf(1.f + __expf(-x)); }
DI float siluf_(float x) { return x * __builtin_amdgcn_rcpf(1.f + __expf(-x)); }
DI float geluf_(float x) { return 0.5f * x * (1.f + erff(x * 0.70710678118654752f)); }
DI float gelu_as_(float v) {
  const float av = fabsf(v), t = __builtin_amdgcn_rcpf(av * 0.2316418882f + 1.0f);
  float q = t * 0.5307027145f + (-0.7265760135f); q = q * t + 0.7107068705f; q = q * t + (-0.142248368f); q = q * t + 0.127414796f; q = q * t;
  const float e = __builtin_amdgcn_exp2f((v * v) * (-0.72134752044f));
  const float m = v * (q * e);
  return v < 0.f ? m : v - m;
}

DI void gload16_asm(bf16x8& d, const void* p) { asm volatile("global_load_dwordx4 %0, %1, off" : "=v"(d) : "v"(p) : "memory"); }
DI void vm_wait0_4(bf16x8& a, bf16x8& b, bf16x8& c, bf16x8& d) {
  asm volatile("s_waitcnt vmcnt(0)" : "+v"(a), "+v"(b), "+v"(c), "+v"(d) : : "memory");
}

template <int WGP, int WGQ, int WP, int WQ, int BK>
DI void gemm_core(f32x16 (&acc)[WP][WQ], const u16* __restrict__ Pg, int ldp, const u16* __restrict__ Qg, int ldq,
                  int K, char* lds) {
  constexpr int BP = WGP * WP * 32, BQ = WGQ * WQ * 32, CPR = BK / 8, ROWB = BK * 2;
  constexpr int RPL = 16 / CPR, RPP = NTHREADS / CPR;
  constexpr int NPP = BP / RPP, NQP = (BQ + RPP - 1) / RPP;
  constexpr bool QPART = (BQ % RPP) != 0;
  constexpr int STG = (BP + NQP * RPP) * ROWB;
  static_assert(BP % RPP == 0, "BP");
  static_assert(!QPART || NQP == 1, "QPART");
  static_assert(2 * STG <= LDS_BYTES, "LDS");
  const int tid = thr(), lane = tid & 63, wave = tid >> 6, n = lane & 31, hh = lane >> 5;
  const int wp = wave / WGQ, wq = wave % WGQ;
  const int lrow = tid / CPR, ccl = tid % CPR;
  const int ccg = ccl ^ ((lrow / RPL) % CPR);
  const int lrowq = QPART ? (lrow % BQ) : lrow;
  const unsigned voffP = (unsigned)(lrow * ldp + ccg * 8) * 2u, voffQ = (unsigned)(lrowq * ldq + ccg * 8) * 2u;
  const char* Pb = (const char*)Pg;
  const char* Qb = (const char*)Qg;
#define GC_STAGE(kt_, buf_)                                                                                  \
  {                                                                                                          \
    const int ko_ = (kt_) * BK * 2;                                                                          \
    char* nb_ = lds + (buf_) * STG + tid * 16;                                                               \
    _Pragma("unroll") for (int i = 0; i < NPP; ++i)                                                          \
        __builtin_amdgcn_global_load_lds((const unsigned*)(Pb + ((size_t)i * RPP * ldp * 2 + ko_) + voffP), \
                                         (__attribute__((address_space(3))) unsigned*)(nb_ + i * RPP * ROWB), 16, 0, 0); \
    _Pragma("unroll") for (int i = 0; i < NQP; ++i)                                                          \
        __builtin_amdgcn_global_load_lds((const unsigned*)(Qb + ((size_t)i * RPP * ldq * 2 + ko_) + voffQ), \
                                         (__attribute__((address_space(3))) unsigned*)(nb_ + (BP + i * RPP) * ROWB), 16, 0, 0); \
  }
  GC_STAGE(0, 0);
  __syncthreads();
  const int nk = K / BK;
  const int swz = (n / RPL) % CPR;
  for (int kt = 0; kt < nk; ++kt) {
    if (kt + 1 < nk) GC_STAGE(kt + 1, (kt + 1) & 1);
    const char* base = lds + (kt & 1) * STG;
#pragma unroll
    for (int ks = 0; ks < BK / 16; ++ks) {
      bf16x8 af[WP], bq[WQ];
      const int co = (((ks * 2 + hh) ^ swz) * 16);
#pragma unroll
      for (int pi = 0; pi < WP; ++pi) af[pi] = *(const bf16x8*)(base + ((wp * WP + pi) * 32 + n) * ROWB + co);
#pragma unroll
      for (int qi = 0; qi < WQ; ++qi) bq[qi] = *(const bf16x8*)(base + (BP + (wq * WQ + qi) * 32 + n) * ROWB + co);
#pragma unroll
      for (int pi = 0; pi < WP; ++pi)
#pragma unroll
        for (int qi = 0; qi < WQ; ++qi) acc[pi][qi] = MFMA(af[pi], bq[qi], acc[pi][qi]);
    }
    __syncthreads();
  }
#undef GC_STAGE
}

namespace pg8 {
#define PG8_LAS __attribute__((address_space(3)))
typedef float f32x4 __attribute__((ext_vector_type(4)));
constexpr int BM = 256, BK = 64, HALF = 128, HTB = HALF * BK * 2, NXCD = 8, WGM = 8;
DI int lds_byte(int r, int c) { const int st = (r >> 4) * 2 + (c >> 5), rr = r & 15, cc = c & 31, ob = rr * 64 + cc * 2; return st * 1024 + (ob ^ (((ob >> 9) & 1) << 5)); }
DI void stage_rc(int b, int& R, int& C) { const int st = b / 1024, sb = b % 1024, swz = sb ^ (((sb >> 9) & 1) << 5); R = (st >> 1) * 16 + swz / 64; C = (st & 1) * 32 + (swz % 64) / 2; }
DI int perm32(int rho) { const int n = rho >> 4, i = rho & 15; return 8 * (i >> 2) + 4 * n + (i & 3); }
struct Unit { int pm, pn; };
struct StaticOrder {
  int nM, nN, nwg, G, c;
  DI void init(int M, int N, int G_, int c_) { nM = M / BM; nN = N / BM; nwg = nM * nN; G = G_; c = c_; }
  DI bool next(int i, Unit& u) const {
    const long L = (long)i * G + c; if (L >= nwg) return false;
    int wgid = (int)L; { const int q = nwg / NXCD, r = nwg % NXCD, xcd = wgid % NXCD, off = wgid / NXCD; wgid = (xcd < r ? xcd * (q + 1) : r * (q + 1) + (xcd - r) * q) + off; }
    const int nig = WGM * nN, gid = wgid / nig, fm = gid * WGM, gsz = (nM - fm) < WGM ? (nM - fm) : WGM;
    u.pm = fm + ((wgid % nig) % gsz); u.pn = (wgid % nig) / gsz; return true;
  }
};
template <class Epi, class Sched>
DI void gemm_phase(PG8_LAS unsigned char* lds, const u16* Ag, int lda, const u16* Btg, int ldb, int K, const Sched& S, const Epi& E) {
  const int tid = threadIdx.x, wid = __builtin_amdgcn_readfirstlane(tid >> 6), lane = tid & 63, wr = wid >> 2, wc = wid & 3, fr = lane & 15, fq = lane >> 4;
  const int nt = K / BK;
  unsigned voffA[2], voffB[2];
#pragma unroll
  for (int i = 0; i < 2; ++i) { int R, C; stage_rc(tid * 16 + i * 8192, R, C); const int Rb = Epi::PERM ? ((R & ~31) + perm32(R & 31)) : R;
    voffA[i] = (unsigned)(R * lda + C) * 2u; voffB[i] = (unsigned)(Rb * ldb + C) * 2u; }
  const size_t kstep = (size_t)(BK * 2);
  const size_t hstepA = (size_t)HALF * lda * 2, hstepB = (size_t)HALF * ldb * 2;
  const size_t tstepA = 2 * hstepA, tstepB = 2 * hstepB;
  const unsigned ldsw = (unsigned)wid * 1024u;
  const int aoff = lds_byte(wr * 64 + fr, fq * 8), boff = lds_byte(wc * 32 + fr, fq * 8);
#define PG8_SA(b, h) (((b) * 2 + (h)) * HTB)
#define PG8_SB(b, h) ((4 + (b) * 2 + (h)) * HTB)
#define PG8_STAGE(bufoff, gbase, voff) do { _Pragma("unroll") for (int _i = 0; _i < 2; ++_i) \
    __builtin_amdgcn_global_load_lds((const unsigned*)((const char*)(gbase) + (voff)[_i]), (PG8_LAS unsigned*)(lds + (bufoff) + ldsw + _i * 8192), 16, 0, 0); } while (0)
#define PG8_LDA(dst, b, h) do { _Pragma("unroll") for (int m = 0; m < 4; ++m) _Pragma("unroll") for (int k = 0; k < 2; ++k) dst[m][k] = *(const PG8_LAS bf16x8*)(lds + PG8_SA(b, h) + aoff + m * 2048 + k * 1024); } while (0)
#define PG8_LDB(dst, b, h) do { _Pragma("unroll") for (int n = 0; n < 2; ++n) _Pragma("unroll") for (int k = 0; k < 2; ++k) dst[n][k] = *(const PG8_LAS bf16x8*)(lds + PG8_SB(b, h) + boff + n * 2048 + k * 1024); } while (0)
#define PG8_MMA(ai, bj, At, Bt) do { __builtin_amdgcn_s_setprio(1); _Pragma("unroll") for (int m = 0; m < 4; ++m) _Pragma("unroll") for (int n = 0; n < 2; ++n) _Pragma("unroll") for (int k = 0; k < 2; ++k) \
    acc[ai][bj][m][n] = __builtin_amdgcn_mfma_f32_16x16x32_bf16(Bt[n][k], At[m][k], acc[ai][bj][m][n], 0, 0, 0); __builtin_amdgcn_s_setprio(0); } while (0)
#define PG8_WAIT_V(n) asm volatile("s_waitcnt vmcnt(" #n ")" ::: "memory")
#define PG8_WAIT_L(n) asm volatile("s_waitcnt lgkmcnt(" #n ")" ::: "memory")
#define PG8_BAR __builtin_amdgcn_s_barrier()
#define PG8_SCHED __builtin_amdgcn_sched_barrier(0)
  Unit cur, nxt; int ui = 0;
  if (!S.next(0, cur)) return;
  f32x4 acc[2][2][4][2];
#pragma unroll
  for (int a = 0; a < 2; ++a)
#pragma unroll
    for (int b = 0; b < 2; ++b)
#pragma unroll
      for (int m = 0; m < 4; ++m)
#pragma unroll
        for (int n = 0; n < 2; ++n) acc[a][b][m][n] = (f32x4){0.f, 0.f, 0.f, 0.f};
  bf16x8 At[4][2], B0[2][2], B1[2][2];
  const char* cA = (const char*)Ag + (size_t)cur.pm * tstepA; const char* cB = (const char*)Btg + (size_t)cur.pn * tstepB;
  PG8_STAGE(PG8_SB(0, 0), cB, voffB); PG8_STAGE(PG8_SA(0, 0), cA, voffA); PG8_STAGE(PG8_SB(0, 1), cB + hstepB, voffB); PG8_STAGE(PG8_SA(0, 1), cA + hstepA, voffA);
  if (wr == 1) PG8_BAR;
  PG8_WAIT_V(4); PG8_BAR;
  PG8_STAGE(PG8_SB(1, 0), cB + kstep, voffB); PG8_STAGE(PG8_SA(1, 0), cA + kstep, voffA); PG8_STAGE(PG8_SB(1, 1), cB + hstepB + kstep, voffB);
  PG8_WAIT_V(6); PG8_BAR;
  for (;;) {
    const bool has_next = S.next(ui + 1, nxt);
    const char* nA = has_next ? (const char*)Ag + (size_t)nxt.pm * tstepA : cA; const char* nB = has_next ? (const char*)Btg + (size_t)nxt.pn * tstepB : cB;
    for (int t = 0; t < nt; t += 2) {
      const bool last = (t == nt - 2);
      const char* a1 = cA + (size_t)(t + 1) * kstep;
      const char* a2 = last ? nA : cA + (size_t)(t + 2) * kstep; const char* b2 = last ? nB : cB + (size_t)(t + 2) * kstep;
      const char* a3 = a2 + kstep; const char* b3 = b2 + kstep;
      PG8_LDB(B0, 0, 0); PG8_SCHED; PG8_LDA(At, 0, 0); PG8_STAGE(PG8_SA(1, 1), a1 + hstepA, voffA);
      PG8_WAIT_L(8); PG8_BAR; PG8_WAIT_L(0); PG8_MMA(0, 0, At, B0); PG8_BAR; PG8_SCHED;
      PG8_LDB(B1, 0, 1); PG8_STAGE(PG8_SB(0, 0), b2, voffB);
      PG8_BAR; PG8_WAIT_L(0); PG8_MMA(0, 1, At, B1); PG8_BAR;
      PG8_LDA(At, 0, 1); PG8_STAGE(PG8_SA(0, 0), a2, voffA);
      PG8_BAR; PG8_WAIT_L(0); PG8_MMA(1, 0, At, B0); PG8_BAR; PG8_SCHED;
      PG8_STAGE(PG8_SB(0, 1), b2 + hstepB, voffB);
      PG8_WAIT_V(6); PG8_BAR; PG8_MMA(1, 1, At, B1); PG8_BAR;
      PG8_LDB(B0, 1, 0); PG8_SCHED; PG8_LDA(At, 1, 0); PG8_STAGE(PG8_SA(0, 1), a2 + hstepA, voffA);
      PG8_WAIT_L(8); PG8_BAR; PG8_WAIT_L(0); PG8_MMA(0, 0, At, B0); PG8_BAR; PG8_SCHED;
      PG8_LDB(B1, 1, 1); PG8_STAGE(PG8_SB(1, 0), b3, voffB);
      PG8_BAR; PG8_WAIT_L(0); PG8_MMA(0, 1, At, B1); PG8_BAR;
      PG8_LDA(At, 1, 1); PG8_STAGE(PG8_SA(1, 0), a3, voffA);
      PG8_BAR; PG8_WAIT_L(0); PG8_MMA(1, 0, At, B0); PG8_BAR; PG8_SCHED;
      PG8_STAGE(PG8_SB(1, 1), b3 + hstepB, voffB);
      PG8_WAIT_V(6); PG8_BAR; PG8_MMA(1, 1, At, B1); PG8_BAR;
    }
    E(acc, cur, wr, wc, fr, fq);
    if (!has_next) break;
#pragma unroll
    for (int a = 0; a < 2; ++a)
#pragma unroll
      for (int b = 0; b < 2; ++b)
#pragma unroll
        for (int m = 0; m < 4; ++m)
#pragma unroll
          for (int n = 0; n < 2; ++n) acc[a][b][m][n] = (f32x4){0.f, 0.f, 0.f, 0.f};
    cur = nxt; cA = nA; cB = nB; ++ui;
  }
  PG8_WAIT_V(0);
  if (wr == 0) PG8_BAR;
  PG8_BAR;
#undef PG8_SA
#undef PG8_SB
#undef PG8_STAGE
#undef PG8_LDA
#undef PG8_LDB
#undef PG8_MMA
#undef PG8_WAIT_V
#undef PG8_WAIT_L
#undef PG8_BAR
#undef PG8_SCHED
}

struct SubUnit { const char* a; const char* b; int kind, pm, pn, nb; };
struct Kinds { int lda0, lda1, ldb0, ldb1, nt0, nt1; };
template <class Epi, class Sched>
DI void gemm_stream2(PG8_LAS unsigned char* lds, const Kinds kd, const Sched& S, const Epi& E) {
  const int tid = threadIdx.x, wid = __builtin_amdgcn_readfirstlane(tid >> 6), lane = tid & 63, wr = wid >> 2, wc = wid & 3, fr = lane & 15, fq = lane >> 4;
  unsigned sRA[2], sRB[2], sC2[2];
#pragma unroll
  for (int i = 0; i < 2; ++i) { int R, C; stage_rc(tid * 16 + i * 8192, R, C); sRA[i] = (unsigned)R; sRB[i] = (unsigned)(Epi::PERM ? ((R & ~31) + perm32(R & 31)) : R); sC2[i] = (unsigned)C * 2u; }
  const size_t kstep = (size_t)(BK * 2);
  const unsigned ldsw = (unsigned)wid * 1024u;
  const int aoff = lds_byte(wr * 64 + fr, fq * 8), boff = lds_byte(wc * 32 + fr, fq * 8);
#define PG8_SA(b, h) (((b) * 2 + (h)) * HTB)
#define PG8_SB(b, h) ((4 + (b) * 2 + (h)) * HTB)
#define PG8_STAGE(bufoff, gbase, rr_, ld2_) do { \
    __builtin_amdgcn_global_load_lds((const unsigned*)((const char*)(gbase) + (__umul24((rr_)[0], (unsigned)(ld2_)) + sC2[0])), (PG8_LAS unsigned*)(lds + (bufoff) + ldsw), 16, 0, 0); \
    __builtin_amdgcn_global_load_lds((const unsigned*)((const char*)(gbase) + (__umul24((rr_)[1], (unsigned)(ld2_)) + sC2[1])), (PG8_LAS unsigned*)(lds + (bufoff) + ldsw + 8192), 16, 0, 0); } while (0)
#define PG8_LDA(dst, b, h) do { _Pragma("unroll") for (int m = 0; m < 4; ++m) _Pragma("unroll") for (int k = 0; k < 2; ++k) dst[m][k] = *(const PG8_LAS bf16x8*)(lds + PG8_SA(b, h) + aoff + m * 2048 + k * 1024); } while (0)
#define PG8_LDB(dst, b, h) do { _Pragma("unroll") for (int n = 0; n < 2; ++n) _Pragma("unroll") for (int k = 0; k < 2; ++k) dst[n][k] = *(const PG8_LAS bf16x8*)(lds + PG8_SB(b, h) + boff + n * 2048 + k * 1024); } while (0)
#define PG8_MMA(ai, bj, At, Bt) do { __builtin_amdgcn_s_setprio(1); _Pragma("unroll") for (int m = 0; m < 4; ++m) _Pragma("unroll") for (int n = 0; n < 2; ++n) _Pragma("unroll") for (int k = 0; k < 2; ++k) \
    acc[ai][bj][m][n] = __builtin_amdgcn_mfma_f32_16x16x32_bf16(Bt[n][k], At[m][k], acc[ai][bj][m][n], 0, 0, 0); __builtin_amdgcn_s_setprio(0); } while (0)
#define PG8_WAIT_V(n) asm volatile("s_waitcnt vmcnt(" #n ")" ::: "memory")
#define PG8_WAIT_L(n) asm volatile("s_waitcnt lgkmcnt(" #n ")" ::: "memory")
#define PG8_BAR __builtin_amdgcn_s_barrier()
#define PG8_SCHED __builtin_amdgcn_sched_barrier(0)
  SubUnit cur, nxt; int ui = 0;
  if (!S.next(0, cur)) return;
  f32x4 acc[2][2][4][2];
#pragma unroll
  for (int a = 0; a < 2; ++a)
#pragma unroll
    for (int b = 0; b < 2; ++b)
#pragma unroll
      for (int m = 0; m < 4; ++m)
#pragma unroll
        for (int n = 0; n < 2; ++n) acc[a][b][m][n] = (f32x4){0.f, 0.f, 0.f, 0.f};
  bf16x8 At[4][2], B0[2][2], B1[2][2];
  const char* cA = cur.a; const char* cB = cur.b;
  int cla2 = (cur.kind ? kd.lda1 : kd.lda0) * 2, clb2 = (cur.kind ? kd.ldb1 : kd.ldb0) * 2;
  size_t chA = (size_t)HALF * cla2, chB = (size_t)HALF * clb2;
  PG8_STAGE(PG8_SB(0, 0), cB, sRB, clb2); PG8_STAGE(PG8_SA(0, 0), cA, sRA, cla2); PG8_STAGE(PG8_SB(0, 1), cB + chB, sRB, clb2); PG8_STAGE(PG8_SA(0, 1), cA + chA, sRA, cla2);
  if (wr == 1) PG8_BAR;
  PG8_WAIT_V(4); PG8_BAR;
  PG8_STAGE(PG8_SB(1, 0), cB + kstep, sRB, clb2); PG8_STAGE(PG8_SA(1, 0), cA + kstep, sRA, cla2); PG8_STAGE(PG8_SB(1, 1), cB + chB + kstep, sRB, clb2);
  PG8_WAIT_V(6); PG8_BAR;
  for (;;) {
    const bool has_next = S.next(ui + 1, nxt);
    if (!has_next) nxt = cur;
    const int nt = cur.kind ? kd.nt1 : kd.nt0;
    const int nla2 = (nxt.kind ? kd.lda1 : kd.lda0) * 2, nlb2 = (nxt.kind ? kd.ldb1 : kd.ldb0) * 2;
    const size_t nhA = (size_t)HALF * nla2, nhB = (size_t)HALF * nlb2;
    for (int t = 0; t < nt; t += 2) {
      const bool last = (t == nt - 2);
      const char* a1 = cA + (size_t)(t + 1) * kstep;
      const char* a2 = last ? nxt.a : cA + (size_t)(t + 2) * kstep; const char* b2 = last ? nxt.b : cB + (size_t)(t + 2) * kstep;
      const char* a3 = a2 + kstep; const char* b3 = b2 + kstep;
      const int xla2 = last ? nla2 : cla2, xlb2 = last ? nlb2 : clb2;
      const size_t xhA = last ? nhA : chA, xhB = last ? nhB : chB;
      PG8_LDB(B0, 0, 0); PG8_SCHED; PG8_LDA(At, 0, 0); PG8_STAGE(PG8_SA(1, 1), a1 + chA, sRA, cla2);
      PG8_WAIT_L(8); PG8_BAR; PG8_WAIT_L(0); PG8_MMA(0, 0, At, B0); PG8_BAR; PG8_SCHED;
      PG8_LDB(B1, 0, 1); PG8_STAGE(PG8_SB(0, 0), b2, sRB, xlb2);
      PG8_BAR; PG8_WAIT_L(0); PG8_MMA(0, 1, At, B1); PG8_BAR;
      PG8_LDA(At, 0, 1); PG8_STAGE(PG8_SA(0, 0), a2, sRA, xla2);
      PG8_BAR; PG8_WAIT_L(0); PG8_MMA(1, 0, At, B0); PG8_BAR; PG8_SCHED;
      PG8_STAGE(PG8_SB(0, 1), b2 + xhB, sRB, xlb2);
      PG8_WAIT_V(6); PG8_BAR; PG8_MMA(1, 1, At, B1); PG8_BAR;
      PG8_LDB(B0, 1, 0); PG8_SCHED; PG8_LDA(At, 1, 0); PG8_STAGE(PG8_SA(0, 1), a2 + xhA, sRA, xla2);
      PG8_WAIT_L(8); PG8_BAR; PG8_WAIT_L(0); PG8_MMA(0, 0, At, B0); PG8_BAR; PG8_SCHED;
      PG8_LDB(B1, 1, 1); PG8_STAGE(PG8_SB(1, 0), b3, sRB, xlb2);
      PG8_BAR; PG8_WAIT_L(0); PG8_MMA(0, 1, At, B1); PG8_BAR;
      PG8_LDA(At, 1, 1); PG8_STAGE(PG8_SA(1, 0), a3, sRA, xla2);
      PG8_BAR; PG8_WAIT_L(0); PG8_MMA(1, 0, At, B0); PG8_BAR; PG8_SCHED;
      PG8_STAGE(PG8_SB(1, 1), b3 + xhB, sRB, xlb2);
      PG8_WAIT_V(6); PG8_BAR; PG8_MMA(1, 1, At, B1); PG8_BAR;
    }
    E(acc, cur, wr, wc, fr, fq);
    if (!has_next) break;
#pragma unroll
    for (int a = 0; a < 2; ++a)
#pragma unroll
      for (int b = 0; b < 2; ++b)
#pragma unroll
        for (int m = 0; m < 4; ++m)
#pragma unroll
          for (int n = 0; n < 2; ++n) acc[a][b][m][n] = (f32x4){0.f, 0.f, 0.f, 0.f};
    cur = nxt; cA = cur.a; cB = cur.b; cla2 = nla2; clb2 = nlb2; chA = nhA; chB = nhB; ++ui;
  }
  PG8_WAIT_V(0);
  if (wr == 0) PG8_BAR;
  PG8_BAR;
#undef PG8_SA
#undef PG8_SB
#undef PG8_STAGE
#undef PG8_LDA
#undef PG8_LDB
#undef PG8_MMA
#undef PG8_WAIT_V
#undef PG8_WAIT_L
#undef PG8_BAR
#undef PG8_SCHED
}
}

DI void phase0(const Params& p, char* lds) {
  u16* wtin = (u16*)(p.ws + OFF_WTIN);
  u16* wtbr = (u16*)(p.ws + OFF_WTBR);
  u16* wtout = (u16*)(p.ws + OFF_WTOUT);
  u16* lruw = (u16*)(p.ws + OFF_LRUW);
  const int tid = thr();
  {
    const int gtid0 = blockIdx.x * NTHREADS + tid, gsz0 = gridDim.x * NTHREADS;
    for (int mi = 0; mi < 10; ++mi) {
      const float* src; u16* dst; int K, N;
      if (mi < 2) { src = p.w_in + (size_t)mi * 1024 * NIN; dst = wtin + (size_t)mi * NIN * 1024; K = 1024; N = NIN; }
      else if (mi < 8) { src = p.w_br + (size_t)(mi - 2) * 512 * 1024; dst = wtbr + (size_t)(mi - 2) * 1024 * 512; K = 512; N = 1024; }
      else { src = p.w_out + (size_t)(mi - 8) * 1024 * 1024; dst = wtout + (size_t)(mi - 8) * 1024 * 1024; K = 1024; N = 1024; }
      const int total = N * (K / 8);
      for (int idx = gtid0; idx < total; idx += gsz0) {
        const int nd = idx % N, kc = idx / N;
        int ns = nd;
        if (mi < 2 && nd >= 2560 && nd < 3584) { int w = nd & 31; ns = (nd & ~31) + ((w & 1) << 4) + (w >> 1); }
        const float* sp = src + (size_t)(kc * 8) * N + ns;
        float v[8];
#pragma unroll
        for (int e = 0; e < 8; ++e) v[e] = sp[(size_t)e * N];
        *(uint4*)(dst + (size_t)nd * K + kc * 8) = make_uint4(pk2(v[0], v[1]), pk2(v[2], v[3]), pk2(v[4], v[5]), pk2(v[6], v[7]));
      }
    }
    for (int idx = gtid0; idx < 2 * 2 * 2 * 8 * 64 * 8; idx += gsz0) {
      const int ic = idx & 7, j = (idx >> 3) & 63, h = (idx >> 9) & 7, which = (idx >> 12) & 1, d = (idx >> 13) & 1, l = idx >> 14;
      const float* sp = (which ? p.lru_wx : p.lru_wa) + (size_t)((l * 2 + d) * 8 + h) * 4096 + (ic * 8) * 64 + j;
      float v[8];
#pragma unroll
      for (int e = 0; e < 8; ++e) v[e] = sp[e * 64];
      *(uint4*)(lruw + (size_t)((((l * 2 + d) * 2 + which) * 8) + h) * 4096 + j * 64 + ic * 8) =
          make_uint4(pk2(v[0], v[1]), pk2(v[2], v[3]), pk2(v[4], v[5]), pk2(v[6], v[7]));
    }
  }
  {
    float* mod = (float*)(p.ws + OFF_MOD);
    float* sc = (float*)lds;
    float* red = (float*)(lds + 9 * 1024 * 4);
    for (int it = blockIdx.x; it < 96; it += gridDim.x) {
      const int l = it / 48, col0 = (it % 48) * 64;
      for (int idx = tid; idx < 9 * 1024; idx += NTHREADS) {
        int r = idx >> 10, k = idx & 1023;
        float v = (r < 8) ? p.c[r * 1024 + k] : p.c_ctx[k];
        sc[idx] = v / (1.f + expf(-v));
      }
      __syncthreads();
      const int j = tid & 63, kg = tid >> 6;
      float a[9];
#pragma unroll
      for (int r = 0; r < 9; ++r) a[r] = 0.f;
      for (int k = kg * 128; k < kg * 128 + 128; ++k) {
        float w = p.w_ada[((size_t)l * 1024 + k) * 3072 + col0 + j];
#pragma unroll
        for (int r = 0; r < 9; ++r) a[r] += sc[r * 1024 + k] * w;
      }
#pragma unroll
      for (int r = 0; r < 9; ++r) red[(kg * 9 + r) * 64 + j] = a[r];
      __syncthreads();
      for (int idx = tid; idx < 9 * 64; idx += NTHREADS) {
        int r = idx >> 6, jj = idx & 63;
        float s = p.b_ada[l * 3072 + col0 + jj];
#pragma unroll
        for (int g = 0; g < 8; ++g) s += red[(g * 9 + r) * 64 + jj];
        mod[(size_t)(l * 9 + r) * 3072 + col0 + jj] = s;
      }
      __syncthreads();
    }
  }
  if (blockIdx.x == 0 && tid == 0) *(unsigned*)(p.ws + OFF_BAR) = 0u;
  const int gtid = blockIdx.x * NTHREADS + tid, gsz = gridDim.x * NTHREADS;
  u16* wsb = (u16*)(p.ws + OFF_WSB);
  for (int i = gtid; i < 2 * 4 * 128 * 128; i += gsz) wsb[i] = f2bf(p.w_s[i]);
  float* biasp = (float*)(p.ws + OFF_BIASP);
  for (int i = gtid; i < 2 * NIN; i += gsz) {
    int l = i / NIN, nd = i % NIN, ns = nd;
    if (nd >= 2560 && nd < 3584) { int w = nd & 31; ns = (nd & ~31) + ((w & 1) << 4) + (w >> 1); }
    biasp[i] = p.b_in[l * NIN + ns];
  }
  float2* rope = (float2*)(p.ws + OFF_ROPE);
  for (int i = gtid; i < 128 * 16; i += gsz) {
    int pos = i >> 4, f = i & 15;
    float inv = powf(10000.f, -(float)f / 16.f);
    float ang = (float)pos * inv;
    rope[i] = make_float2(cosf(ang), sinf(ang));
  }
}

DI void phase0b(const Params& p) {
  const float* mod = (const float*)(p.ws + OFF_MOD);
  u16* u = (u16*)(p.ws + OFF_U);
  const size_t total = (size_t)NTOK * 128;
  for (size_t idx = (size_t)blockIdx.x * NTHREADS + thr(); idx < total; idx += (size_t)gridDim.x * NTHREADS) {
    int tok = (int)(idx >> 7), d0 = (int)(idx & 127) * 8;
    int bidx = tok < T_LAT ? (tok >> 13) : 8;
    const float* src = tok < T_LAT ? p.x + (size_t)tok * 1024 + d0 : p.ctx + (size_t)(tok - T_LAT) * 1024 + d0;
    const float* mb = mod + (size_t)bidx * 3072;
    float4 a = *(const float4*)src, b = *(const float4*)(src + 4);
    float4 s0 = *(const float4*)(mb + 1024 + d0), s1 = *(const float4*)(mb + 1024 + d0 + 4);
    float4 h0 = *(const float4*)(mb + d0), h1 = *(const float4*)(mb + d0 + 4);
    uint4 o;
    o.x = pk2(a.x * (1.f + s0.x) + h0.x, a.y * (1.f + s0.y) + h0.y);
    o.y = pk2(a.z * (1.f + s0.z) + h0.z, a.w * (1.f + s0.w) + h0.w);
    o.z = pk2(b.x * (1.f + s1.x) + h1.x, b.y * (1.f + s1.y) + h1.y);
    o.w = pk2(b.z * (1.f + s1.z) + h1.z, b.w * (1.f + s1.w) + h1.w);
    *(uint4*)(u + (size_t)tok * 1024 + d0) = o;
  }
}

struct EpiP1 {
  static constexpr bool PERM = true, AFTER_DRAIN = false;
  u16* z; u16* vtl; u16* vtc; const float* biasp; const float2* rope;
  DI void operator()(const pg8::f32x4 (&acc)[2][2][4][2], const pg8::Unit& u, int wr, int wc, int fr, int fq) const {
    const int slot = u.pn >> 1;
    const int cl0 = (u.pn & 1) * 256 + wc * 32 + 8 * fq;
    const int zcol = (slot == 8 ? 7 : slot) * 512;
    pg8::f32x4 bv[2][2];
#pragma unroll
    for (int bj = 0; bj < 2; ++bj)
#pragma unroll
      for (int n = 0; n < 2; ++n) bv[bj][n] = *(const pg8::f32x4*)(biasp + slot * 512 + cl0 + bj * 128 + 4 * n);
#pragma unroll
    for (int ai = 0; ai < 2; ++ai)
#pragma unroll
      for (int m = 0; m < 4; ++m) {
        const int tok = u.pm * 256 + ai * 128 + wr * 64 + m * 16 + fr;
        const bool latent = tok < T_LAT;
#pragma unroll
        for (int bj = 0; bj < 2; ++bj) {
          const int ch = cl0 + bj * 128;
          pg8::f32x4 v0 = acc[ai][bj][m][0] + bv[bj][0], v1 = acc[ai][bj][m][1] + bv[bj][1];
          if (slot <= 1) {
#pragma unroll
            for (int j = 0; j < 4; ++j) { v0[j] = gelu_as_(v0[j]); v1[j] = gelu_as_(v1[j]); }
          } else if (slot == 2 || slot == 4 || slot == 8) {
#pragma unroll
            for (int j = 0; j < 4; ++j) { v0[j] = siluf_(v0[j]); v1[j] = siluf_(v1[j]); }
          } else if (slot == 5 || slot == 6) {
            if (latent) {
              const int sidx = ch & 63, i0 = (sidx & 31) >> 1;
              const int pos = (sidx >> 5) ? (tok & 63) : ((tok & 8191) >> 6);
              const float4 ca = *(const float4*)(rope + pos * 16 + i0), cb = *(const float4*)(rope + pos * 16 + i0 + 2);
              float t0 = v0[0] * ca.x - v0[1] * ca.y, t1 = v0[0] * ca.y + v0[1] * ca.x;
              float t2 = v0[2] * ca.z - v0[3] * ca.w, t3 = v0[2] * ca.w + v0[3] * ca.z;
              v0[0] = t0; v0[1] = t1; v0[2] = t2; v0[3] = t3;
              t0 = v1[0] * cb.x - v1[1] * cb.y; t1 = v1[0] * cb.y + v1[1] * cb.x;
              t2 = v1[2] * cb.z - v1[3] * cb.w; t3 = v1[2] * cb.w + v1[3] * cb.z;
              v1[0] = t0; v1[1] = t1; v1[2] = t2; v1[3] = t3;
            }
            if (slot == 5) { v0 *= 0.18033688011112042f; v1 *= 0.18033688011112042f; }
          }
          if (slot == 7) {
            u16* dst; int stride;
            if (latent) { dst = vtl + ((size_t)((tok >> 13) * 512 + ch) * 8192 + (tok & 8191)); stride = 8192; }
            else { const int tc = tok - T_LAT; dst = vtc + ((size_t)((tc >> 8) * 512 + ch) * 256 + (tc & 255)); stride = 256; }
#pragma unroll
            for (int j = 0; j < 4; ++j) { dst[(size_t)j * stride] = f2bf(v0[j]); dst[(size_t)(4 + j) * stride] = f2bf(v1[j]); }
          } else {
            *(uint4*)(z + (size_t)tok * ZC + zcol + ch) = make_uint4(pk2(v0[0], v0[1]), pk2(v0[2], v0[3]), pk2(v1[0], v1[1]), pk2(v1[2], v1[3]));
          }
        }
      }
  }
};

DI void phase1(const Params& p, int l, char* lds) {
  EpiP1 E;
  E.z = (u16*)(p.ws + OFF_Z); E.vtl = (u16*)(p.ws + OFF_VTL); E.vtc = (u16*)(p.ws + OFF_VTC);
  E.biasp = (const float*)(p.ws + OFF_BIASP) + l * NIN; E.rope = (const float2*)(p.ws + OFF_ROPE);
  pg8::StaticOrder S;
  S.init(NTOK, 4608, gridDim.x, blockIdx.x);
  pg8::gemm_phase<EpiP1, pg8::StaticOrder>((PG8_LAS unsigned char*)lds, (const u16*)(p.ws + OFF_U), 1024,
                                          (const u16*)(p.ws + OFF_WTIN) + (size_t)l * NIN * 1024, 1024, 1024, S, E);
}

DI void sgu_tile(const Params& p, int l, int tile, char* lds) {
  constexpr int VS = 136;
  u16* z = (u16*)(p.ws + OFF_Z) + (size_t)tile * 128 * ZC;
  u16* vaT = (u16*)lds;
  const u16* wsb = (const u16*)(p.ws + OFF_WSB) + (size_t)l * 4 * 128 * 128;
  const int tid = thr(), lane = tid & 63, wave = tid >> 6, n = lane & 31, hh = lane >> 5;
  {
    float g[8], bb[8];
#pragma unroll
    for (int e = 0; e < 8; ++e) { g[e] = p.sgu_ln_g[l * 512 + lane * 8 + e]; bb[e] = p.sgu_ln_b[l * 512 + lane * 8 + e]; }
#pragma unroll
    for (int qq = 0; qq < 16; ++qq) {
      const int q = wave * 16 + qq;
      uint4 raw = *(const uint4*)(z + (size_t)q * ZC + 512 + lane * 8);
      float xv[8] = {bflo(raw.x), bfhi(raw.x), bflo(raw.y), bfhi(raw.y), bflo(raw.z), bfhi(raw.z), bflo(raw.w), bfhi(raw.w)};
      float s = 0.f;
#pragma unroll
      for (int e = 0; e < 8; ++e) s += xv[e];
#pragma unroll
      for (int o = 32; o > 0; o >>= 1) s += __shfl_xor(s, o);
      const float mean = s * (1.f / 512.f);
      float ss = 0.f;
#pragma unroll
      for (int e = 0; e < 8; ++e) { xv[e] -= mean; ss += xv[e] * xv[e]; }
#pragma unroll
      for (int o = 32; o > 0; o >>= 1) ss += __shfl_xor(ss, o);
      const float rstd = rsqrtf(ss * (1.f / 512.f) + 1e-5f);
#pragma unroll
      for (int e = 0; e < 8; ++e)
        vaT[(lane * 8 + e) * VS + ((((q >> 3) ^ lane) & 15) << 3) + (q & 7)] = f2bf(xv[e] * rstd * g[e] + bb[e]);
    }
  }
  __syncthreads();
  const int grp = wave >> 1, chalf = wave & 1;
  f32x16 acc[2][4];
#pragma unroll
  for (int a = 0; a < 2; ++a)
#pragma unroll
    for (int b = 0; b < 4; ++b)
#pragma unroll
      for (int i = 0; i < 16; ++i) acc[a][b][i] = 0.f;
#pragma unroll 4
  for (int ks = 0; ks < 8; ++ks) {
    bf16x8 af[2], bq[4];
#pragma unroll
    for (int ci = 0; ci < 2; ++ci)
    {
      const int row = grp * 128 + chalf * 64 + ci * 32 + n;
      af[ci] = *(const bf16x8*)(vaT + row * VS + ((((ks * 2 + hh) ^ (row >> 3)) & 15) << 3));
    }
#pragma unroll
    for (int pt = 0; pt < 4; ++pt)
      bq[pt] = *(const bf16x8*)(wsb + (size_t)(grp * 128 + pt * 32 + n) * 128 + ks * 16 + hh * 8);
#pragma unroll
    for (int ci = 0; ci < 2; ++ci)
#pragma unroll
      for (int pt = 0; pt < 4; ++pt) acc[ci][pt] = MFMA(af[ci], bq[pt], acc[ci][pt]);
  }
#pragma unroll
  for (int pt = 0; pt < 4; ++pt) {
    const int tp = pt * 32 + n;
    const float bsv = p.b_s[(l * 4 + grp) * 128 + tp];
    u16* zr = z + (size_t)tp * ZC;
#pragma unroll
    for (int ci = 0; ci < 2; ++ci)
#pragma unroll
      for (int g = 0; g < 4; ++g) {
        const int c = grp * 128 + chalf * 64 + ci * 32 + 8 * g + 4 * hh;
        uint2 ua = *(const uint2*)(zr + c), sa = *(const uint2*)(zr + 1024 + c);
        uint2 o;
        o.x = pk2((acc[ci][pt][4 * g + 0] + bsv) * bflo(ua.x) * bflo(sa.x), (acc[ci][pt][4 * g + 1] + bsv) * bfhi(ua.x) * bfhi(sa.x));
        o.y = pk2((acc[ci][pt][4 * g + 2] + bsv) * bflo(ua.y) * bflo(sa.y), (acc[ci][pt][4 * g + 3] + bsv) * bfhi(ua.y) * bfhi(sa.y));
        *(uint2*)(zr + c) = o;
      }
  }
  __syncthreads();
}

template <int DIR>
DI void lru_unit(const Params& p, int l, int tile, int h, int ct, const u16* xs, u16* z, const u16* lruw, int lane) {
  constexpr int XS = 520;
  const int n = lane & 31, hh = lane >> 5;
  const int ch = h * 64 + ct * 32 + n;
  const u16* Wr = lruw + (size_t)((((l * 2 + DIR) * 2 + 0) * 8) + h) * 4096 + (ct * 32 + n) * 64;
  const u16* Wi = lruw + (size_t)((((l * 2 + DIR) * 2 + 1) * 8) + h) * 4096 + (ct * 32 + n) * 64;
  bf16x8 wr[4], wi[4];
#pragma unroll
  for (int ks = 0; ks < 4; ++ks) {
    wr[ks] = *(const bf16x8*)(Wr + ks * 16 + hh * 8);
    wi[ks] = *(const bf16x8*)(Wi + ks * 16 + hh * 8);
  }
  const int pidx = (l * 2 + DIR) * 512 + ch;
  const float ba = p.lru_ba[pidx], bx = p.lru_bx[pidx];
  const float sp = log1pf(expf(-p.lru_lam[pidx]));
  const bool first = DIR == 0 ? (hh == 0) : (hh == 1);
  float Ch = 0.f, Cp = 1.f;
#pragma unroll 1
  for (int rti = 0; rti < 4; ++rti) {
    const int rt = DIR == 0 ? rti : 3 - rti;
    u16* zc = z + (size_t)(rt * 32 + 4 * hh) * ZC + ch;
    unsigned sgr[16], oldr[16];
#pragma unroll
    for (int i = 0; i < 16; ++i)
      asm volatile("global_load_ushort %0, %1, off" : "=v"(sgr[i]) : "v"(zc + (size_t)((i & 3) + 8 * (i >> 2)) * ZC + 4 * 512) : "memory");
    if (DIR == 1) {
#pragma unroll
      for (int i = 0; i < 16; ++i)
        asm volatile("global_load_ushort %0, %1, off" : "=v"(oldr[i]) : "v"(zc + (size_t)((i & 3) + 8 * (i >> 2)) * ZC + 1 * 512) : "memory");
    }
    f32x16 A, B;
#pragma unroll
    for (int i = 0; i < 16; ++i) { A[i] = 0.f; B[i] = 0.f; }
#pragma unroll
    for (int ks = 0; ks < 4; ++ks) {
      const bf16x8 xa = *(const bf16x8*)(xs + (rt * 32 + n) * XS + h * 64 + ks * 16 + hh * 8);
      A = MFMA(xa, wr[ks], A);
      B = MFMA(xa, wi[ks], B);
    }
    const u16* xcol = xs + (rt * 32 + 4 * hh) * XS + ch;
#pragma unroll
    for (int i = 0; i < 16; ++i) {
      const float xcv = bf2f(xcol[((i & 3) + 8 * (i >> 2)) * XS]);
      const float r = sigmoidf_(A[i] + ba), ig = sigmoidf_(B[i] + bx);
      const float la = -8.f * r * sp;
      const float av = __expf(la);
      A[i] = av;
      B[i] = __builtin_amdgcn_sqrtf(fmaxf(1.f - av * av, 0.f)) * (ig * xcv);
    }
#pragma unroll
    for (int qi = 0; qi < 4; ++qi) {
      const int q = DIR == 0 ? qi : 3 - qi;
      float lp = 1.f, lh = 0.f;
#pragma unroll
      for (int ci = 0; ci < 4; ++ci) {
        const int c = DIR == 0 ? ci : 3 - ci;
        const float a = A[4 * q + c], b = B[4 * q + c];
        lh = a * lh + b; lp = lp * a;
        A[4 * q + c] = lp; B[4 * q + c] = lh;
      }
      const float pp = __shfl_xor(lp, 32), ph = __shfl_xor(lh, 32);
      const float A0 = first ? lp : pp, B0 = first ? lh : ph, A1 = first ? pp : lp, B1 = first ? ph : lh;
      const float inh = first ? Ch : (A0 * Ch + B0), inp = first ? Cp : (A0 * Cp);
#pragma unroll
      for (int c = 0; c < 4; ++c) {
        B[4 * q + c] = B[4 * q + c] + A[4 * q + c] * inh;
        A[4 * q + c] = A[4 * q + c] * inp;
      }
      Ch = A1 * (A0 * Ch + B0) + B1;
      Cp = A1 * A0 * Cp;
    }
    asm volatile("s_waitcnt vmcnt(0)" : "+v"(sgr[0]), "+v"(sgr[1]), "+v"(sgr[2]), "+v"(sgr[3]), "+v"(sgr[4]), "+v"(sgr[5]), "+v"(sgr[6]), "+v"(sgr[7]),
                 "+v"(sgr[8]), "+v"(sgr[9]), "+v"(sgr[10]), "+v"(sgr[11]), "+v"(sgr[12]), "+v"(sgr[13]), "+v"(sgr[14]), "+v"(sgr[15]) : : "memory");
    if (DIR == 1)
      asm volatile("" : "+v"(oldr[0]), "+v"(oldr[1]), "+v"(oldr[2]), "+v"(oldr[3]), "+v"(oldr[4]), "+v"(oldr[5]), "+v"(oldr[6]), "+v"(oldr[7]),
                   "+v"(oldr[8]), "+v"(oldr[9]), "+v"(oldr[10]), "+v"(oldr[11]), "+v"(oldr[12]), "+v"(oldr[13]), "+v"(oldr[14]), "+v"(oldr[15]) : : "memory");
#pragma unroll
    for (int i = 0; i < 16; ++i) {
      u16* zr = zc + (size_t)((i & 3) + 8 * (i >> 2)) * ZC;
      const float sg = __uint_as_float(sgr[i] << 16);
      if (DIR == 0) {
        zr[1 * 512] = f2bf(B[i] * sg);
        zr[2 * 512] = f2bf(A[i] * sg);
      } else {
        const float old = __uint_as_float(oldr[i] << 16);
        zr[1 * 512] = f2bf(old + B[i] * sg);
        zr[4 * 512] = f2bf(A[i] * sg);
      }
    }
  }
  if (hh == 0) {
    float* aggA = (float*)(p.ws + OFF_AGG);
    float* aggH = (float*)(p.ws + OFF_AGG + AGG_HALF);
    aggA[(size_t)(tile * 2 + DIR) * 512 + ch] = Cp;
    aggH[(size_t)(tile * 2 + DIR) * 512 + ch] = Ch;
  }
}

DI void lru_tile(const Params& p, int l, int tile, char* lds) {
  constexpr int XS = 520;
  u16* xs = (u16*)lds;
  const u16* zall = (const u16*)(p.ws + OFF_Z);
  const int tid = thr();
  int seqbase, pos0, seqlen;
  if (tile < 512) { seqbase = (tile >> 6) * 8192; pos0 = (tile & 63) * 128; seqlen = 8192; }
  else { int j = tile - 512; seqbase = T_LAT + (j >> 1) * 256; pos0 = (j & 1) * 128; seqlen = 256; }
  {
    const int c0 = (tid & 63) * 8, t0 = (tid >> 6) * 16;
    float cw[4][8], cb[8];
#pragma unroll
    for (int e = 0; e < 8; ++e) {
      cb[e] = p.conv_b[l * 512 + c0 + e];
#pragma unroll
      for (int j = 0; j < 4; ++j) cw[j][e] = p.conv_w[(l * 4 + j) * 512 + c0 + e];
    }
    float r0[8], r1[8], r2[8], r3[8];
    auto ldrow = [&](int pos, float (&r)[8]) {
      if (pos >= 0 && pos < seqlen) {
        uint4 raw = *(const uint4*)(zall + (size_t)(seqbase + pos) * ZC + 3 * 512 + c0);
        r[0] = bflo(raw.x); r[1] = bfhi(raw.x); r[2] = bflo(raw.y); r[3] = bfhi(raw.y);
        r[4] = bflo(raw.z); r[5] = bfhi(raw.z); r[6] = bflo(raw.w); r[7] = bfhi(raw.w);
      } else {
#pragma unroll
        for (int e = 0; e < 8; ++e) r[e] = 0.f;
      }
    };
    ldrow(pos0 + t0 - 2, r0);
    ldrow(pos0 + t0 - 1, r1);
    ldrow(pos0 + t0, r2);
#pragma unroll
    for (int i = 0; i < 16; ++i) {
      ldrow(pos0 + t0 + i + 1, r3);
      float o[8];
#pragma unroll
      for (int e = 0; e < 8; ++e) o[e] = cb[e] + cw[0][e] * r0[e] + cw[1][e] * r1[e] + cw[2][e] * r2[e] + cw[3][e] * r3[e];
      *(uint4*)(xs + (t0 + i) * XS + c0) = make_uint4(pk2(o[0], o[1]), pk2(o[2], o[3]), pk2(o[4], o[5]), pk2(o[6], o[7]));
#pragma unroll
      for (int e = 0; e < 8; ++e) { r0[e] = r1[e]; r1[e] = r2[e]; r2[e] = r3[e]; }
    }
  }
  __syncthreads();
  {
    const int lane = tid & 63, h = tid >> 6;
    u16* z = (u16*)(p.ws + OFF_Z) + (size_t)tile * 128 * ZC;
    const u16* lruw = (const u16*)(p.ws + OFF_LRUW);
    for (int ct = 0; ct < 2; ++ct) lru_unit<0>(p, l, tile, h, ct, xs, z, lruw, lane);
    for (int ct = 0; ct < 2; ++ct) lru_unit<1>(p, l, tile, h, ct, xs, z, lruw, lane);
  }
  __syncthreads();
}

DI void attn_item(const Params& p, int l, int item, char* lds) {
  float* rpbs = (float*)lds;
  const int tid = thr(), lane = tid & 63, h = tid >> 6, n = lane & 31, hh = lane >> 5;
  for (int i = tid; i < 8 * 465; i += NTHREADS) rpbs[i] = p.rpb[(size_t)l * 8 * 465 + i] * 1.4426950408889634f;
  __syncthreads();
  u16* z = (u16*)(p.ws + OFF_Z);
  const u16* vtl = (const u16*)(p.ws + OFF_VTL);
  const u16* vtc = (const u16*)(p.ws + OFF_VTC);
  const bool latent = item < 1024;
  int b, r = 0, qbase, r0 = 0;
  if (latent) { b = item >> 7; r = item & 127; qbase = b * 8192 + r * 64; r0 = min(max(r - 4, 0), 120); }
  else { int j = item - 1024; b = j >> 2; qbase = T_LAT + b * 256 + (j & 3) * 64; }
  const int nsteps = latent ? 12 : 4;
  const float* rp = rpbs + h * 465;
  {
    char* qlds = lds + 16384 + h * 8192 + lane * 16;
    char* kst = lds + 81920 + h * 9728;
    char* vst = kst + 4608;
#pragma unroll
    for (int t = 0; t < 2; ++t)
#pragma unroll
      for (int ks = 0; ks < 4; ++ks)
        *(bf16x8*)(qlds + t * 4096 + ks * 1024) = *(const bf16x8*)(z + (size_t)(qbase + t * 32 + n) * ZC + 5 * 512 + h * 64 + ks * 16 + hh * 8);
    f32x16 O[2][2];
#pragma unroll
    for (int t = 0; t < 2; ++t)
#pragma unroll
      for (int i = 0; i < 16; ++i) { O[t][0][i] = 0.f; O[t][1][i] = 0.f; }
    float m[2] = {-1e30f, -1e30f}, lsum[2] = {0.f, 0.f};
    int qcs[2]; unsigned long long vmask[2];
#pragma unroll
    for (int t = 0; t < 2; ++t) { qcs[t] = t * 32 + n; const int c0 = min(max(qcs[t] - 8, 0), 48); vmask[t] = 0xFFFFull << c0; }
    const int krow0 = lane >> 3, kch = lane & 7, vrow0 = lane >> 2, vch = lane & 3;
    bf16x8 R[8];
    auto issue = [&](int st) {
      int kt0, koff, vld;
      const u16* vb;
      if (st < 8) { kt0 = T_LAT + b * 256 + st * 32; vb = vtc + (size_t)(b * 512 + h * 64) * 256; koff = st * 32; vld = 256; }
      else { const int kr = r0 + ((st - 8) >> 1), half = (st - 8) & 1; kt0 = b * 8192 + kr * 64 + half * 32;
             vb = vtl + (size_t)(b * 512 + h * 64) * 8192; koff = kr * 64 + half * 32; vld = 8192; }
#pragma unroll
      for (int i = 0; i < 4; ++i) {
        const int row = krow0 + 8 * i;
        const int key = (row & 19) | ((row & 4) << 1) | ((row & 8) >> 1);
        gload16_asm(R[i], z + (size_t)(kt0 + key) * ZC + 6 * 512 + h * 64 + kch * 8);
      }
#pragma unroll
      for (int i = 0; i < 4; ++i) gload16_asm(R[4 + i], vb + (size_t)(vrow0 + 16 * i) * vld + koff + vch * 8);
    };
    auto commit = [&]() {
      vm_wait0_4(R[0], R[1], R[2], R[3]);
      vm_wait0_4(R[4], R[5], R[6], R[7]);
      asm volatile("" ::: "memory");
#pragma unroll
      for (int i = 0; i < 4; ++i) *(bf16x8*)(kst + (krow0 + 8 * i) * 144 + kch * 16) = R[i];
#pragma unroll
      for (int i = 0; i < 4; ++i) *(bf16x8*)(vst + (vrow0 + 16 * i) * 80 + vch * 16) = R[4 + i];
      asm volatile("s_waitcnt lgkmcnt(0)" ::: "memory");
    };
    const int ns32 = nsteps * 2;
    issue(0);
    commit();
    for (int st = 0; st < ns32; ++st) {
      if (st + 1 < ns32) issue(st + 1);
      bf16x8 Ku[4], Vu[4];
#pragma unroll
      for (int ks = 0; ks < 4; ++ks) Ku[ks] = *(const bf16x8*)(kst + n * 144 + (ks * 2 + hh) * 16);
#pragma unroll
      for (int s2 = 0; s2 < 2; ++s2)
#pragma unroll
        for (int dt = 0; dt < 2; ++dt) Vu[s2 * 2 + dt] = *(const bf16x8*)(vst + (dt * 32 + n) * 80 + (s2 * 2 + hh) * 16);
#pragma unroll
      for (int t = 0; t < 2; ++t) {
        f32x16 S;
#pragma unroll
        for (int i = 0; i < 16; ++i) S[i] = 0.f;
#pragma unroll
        for (int ks = 0; ks < 4; ++ks) S = MFMA(Ku[ks], *(const bf16x8*)(qlds + t * 4096 + ks * 1024), S);
        if (st >= 8) {
          const int kr = r0 + ((st - 8) >> 1), half = (st - 8) & 1;
          const int kbase = half * 32 + 8 * hh;
          const float* rrow = rp + (kr - r + 7) * 31;
          const int dbase = kbase + 15 - qcs[t];
          const unsigned w = (unsigned)(vmask[t] >> kbase);
#pragma unroll
          for (int i = 0; i < 16; ++i) {
            const int pos = 16 * (i >> 3) + (i & 7);
            const float bias = rrow[min(max(dbase + pos, 0), 30)];
            S[i] = ((w >> pos) & 1u) ? (S[i] + bias) : -1e30f;
          }
        }
        float mt = -1e30f;
#pragma unroll
        for (int i = 0; i < 16; ++i) mt = fmaxf(mt, S[i]);
        mt = fmaxf(mt, __shfl_xor(mt, 32));
        if (__builtin_amdgcn_ballot_w64(mt > m[t] + 8.f) != 0ull) {
          const float mn = fmaxf(m[t], mt);
          const float alpha = __builtin_amdgcn_exp2f(m[t] - mn);
          m[t] = mn;
          lsum[t] *= alpha;
#pragma unroll
          for (int i = 0; i < 16; ++i) { O[t][0][i] *= alpha; O[t][1][i] *= alpha; }
        }
        float ps = 0.f;
#pragma unroll
        for (int i = 0; i < 16; ++i) { const float e = __builtin_amdgcn_exp2f(S[i] - m[t]); S[i] = e; ps += e; }
        lsum[t] += ps;
#pragma unroll
        for (int s2 = 0; s2 < 2; ++s2) {
          typedef unsigned u32x4 __attribute__((ext_vector_type(4)));
          u32x4 pw;
          pw[0] = pk2(S[8 * s2 + 0], S[8 * s2 + 1]);
          pw[1] = pk2(S[8 * s2 + 2], S[8 * s2 + 3]);
          pw[2] = pk2(S[8 * s2 + 4], S[8 * s2 + 5]);
          pw[3] = pk2(S[8 * s2 + 6], S[8 * s2 + 7]);
          const bf16x8 Pf = __builtin_bit_cast(bf16x8, pw);
#pragma unroll
          for (int dt = 0; dt < 2; ++dt) O[t][dt] = MFMA(Vu[s2 * 2 + dt], Pf, O[t][dt]);
        }
      }
      if (st + 1 < ns32) { asm volatile("" ::: "memory"); commit(); }
    }
#pragma unroll
    for (int t = 0; t < 2; ++t) {
      const float ltot = lsum[t] + __shfl_xor(lsum[t], 32);
      const float inv = __builtin_amdgcn_rcpf(ltot);
      u16* zr = z + (size_t)(qbase + t * 32 + n) * ZC;
#pragma unroll
      for (int dt = 0; dt < 2; ++dt)
#pragma unroll
        for (int g = 0; g < 4; ++g) {
          const int d0 = h * 64 + dt * 32 + 8 * g + 4 * hh;
          const uint2 cg2 = *(const uint2*)(zr + 7 * 512 + d0);
          uint2 o;
          o.x = pk2(O[t][dt][4 * g + 0] * inv * bflo(cg2.x), O[t][dt][4 * g + 1] * inv * bfhi(cg2.x));
          o.y = pk2(O[t][dt][4 * g + 2] * inv * bflo(cg2.y), O[t][dt][4 * g + 3] * inv * bfhi(cg2.y));
          *(uint2*)(zr + 5 * 512 + d0) = o;
        }
    }
  }
  __syncthreads();
}

DI void phase2(const Params& p, int l, char* lds) {
  const int ntile = (l == 0) ? 528 : 528;
  const int nattn = (l == 0) ? 1056 : 1024;
  for (int it = blockIdx.x; it < ntile + nattn; it += gridDim.x) {
    if (it < ntile) {
      if (it < 512 || l == 0) sgu_tile(p, l, it, lds);
      lru_tile(p, l, it, lds);
    } else {
      attn_item(p, l, it - ntile, lds);
    }
  }
}

DI void phase2b(const Params& p, int l, char* lds) {
  const float* aggA = (const float*)(p.ws + OFF_AGG);
  const float* aggH = (const float*)(p.ws + OFF_AGG + AGG_HALF);
  float* car = (float*)lds;
  const int tid = thr();
  const int ntile = (l == 0) ? 528 : 512;
  for (int tile = blockIdx.x; tile < ntile; tile += gridDim.x) {
    {
      const int ch = tid;
      float hf = 0.f, hr = 0.f;
      if (tile < 512) {
        const int b = tile >> 6, nn = tile & 63;
        for (int j = 0; j < 2; ++j) { int t = 512 + 2 * b + j; hf = aggA[(size_t)(t * 2) * 512 + ch] * hf + aggH[(size_t)(t * 2) * 512 + ch]; }
        for (int j = 0; j < nn; ++j) { int t = 64 * b + j; hf = aggA[(size_t)(t * 2) * 512 + ch] * hf + aggH[(size_t)(t * 2) * 512 + ch]; }
        for (int j = 1; j >= 0; --j) { int t = 512 + 2 * b + j; hr = aggA[(size_t)(t * 2 + 1) * 512 + ch] * hr + aggH[(size_t)(t * 2 + 1) * 512 + ch]; }
        for (int j = 63; j > nn; --j) { int t = 64 * b + j; hr = aggA[(size_t)(t * 2 + 1) * 512 + ch] * hr + aggH[(size_t)(t * 2 + 1) * 512 + ch]; }
      } else {
        const int b = (tile - 512) >> 1, nn = (tile - 512) & 1;
        if (nn == 1) { int t = 512 + 2 * b; hf = aggH[(size_t)(t * 2) * 512 + ch]; }
        else { int t = 512 + 2 * b + 1; hr = aggH[(size_t)(t * 2 + 1) * 512 + ch]; }
      }
      car[ch] = hf;
      car[512 + ch] = hr;
    }
    __syncthreads();
    {
      const int c0 = (tid & 63) * 8, t0 = (tid >> 6) * 16;
      float cf[8], cr[8];
#pragma unroll
      for (int e = 0; e < 8; ++e) { cf[e] = car[c0 + e]; cr[e] = car[512 + c0 + e]; }
      u16* z = (u16*)(p.ws + OFF_Z) + (size_t)tile * 128 * ZC;
#pragma unroll 4
      for (int i = 0; i < 16; ++i) {
        u16* zr = z + (size_t)(t0 + i) * ZC + c0;
        const uint4 yp = *(const uint4*)(zr + 512), pf = *(const uint4*)(zr + 1024), pr = *(const uint4*)(zr + 2048);
        uint4 o;
        o.x = pk2(bflo(yp.x) + bflo(pf.x) * cf[0] + bflo(pr.x) * cr[0], bfhi(yp.x) + bfhi(pf.x) * cf[1] + bfhi(pr.x) * cr[1]);
        o.y = pk2(bflo(yp.y) + bflo(pf.y) * cf[2] + bflo(pr.y) * cr[2], bfhi(yp.y) + bfhi(pf.y) * cf[3] + bfhi(pr.y) * cr[3]);
        o.z = pk2(bflo(yp.z) + bflo(pf.z) * cf[4] + bflo(pr.z) * cr[4], bfhi(yp.z) + bfhi(pf.z) * cf[5] + bfhi(pr.z) * cr[5]);
        o.w = pk2(bflo(yp.w) + bflo(pf.w) * cf[6] + bflo(pr.w) * cr[6], bfhi(yp.w) + bfhi(pf.w) * cf[7] + bfhi(pr.w) * cr[7]);
        *(uint4*)(zr + 512) = o;
      }
    }
    __syncthreads();
  }
}

struct EpiP3 {
  static constexpr bool PERM = true, AFTER_DRAIN = false;
  u16* gs;
  u16* mbuf; const float* biasg;
  DI void operator()(const pg8::f32x4 (&acc)[2][2][4][2], const pg8::SubUnit& u, int wr, int wc, int fr, int fq) const {
    asm volatile("" : "+v"(fr), "+v"(fq));
    const int cl0 = wc * 32 + 8 * fq;
    if (u.kind == 0) {
      pg8::f32x4 bv[2][2];
#pragma unroll
      for (int bj = 0; bj < 2; ++bj)
#pragma unroll
        for (int n = 0; n < 2; ++n) bv[bj][n] = *(const pg8::f32x4*)(biasg + u.nb * 1024 + u.pn * 256 + cl0 + bj * 128 + 4 * n);
#pragma unroll
      for (int ai = 0; ai < 2; ++ai)
#pragma unroll
        for (int m = 0; m < 4; ++m) {
          const int rl = ai * 128 + wr * 64 + m * 16 + fr;
#pragma unroll
          for (int bj = 0; bj < 2; ++bj) {
            const pg8::f32x4 v0 = acc[ai][bj][m][0] + bv[bj][0], v1 = acc[ai][bj][m][1] + bv[bj][1];
            *(uint4*)(gs + rl * 256 + cl0 + bj * 128) =
                make_uint4(pk2(sigmoidf_(v0[0]), sigmoidf_(v0[1])), pk2(sigmoidf_(v0[2]), sigmoidf_(v0[3])),
                           pk2(sigmoidf_(v1[0]), sigmoidf_(v1[1])), pk2(sigmoidf_(v1[2]), sigmoidf_(v1[3])));
          }
        }
    } else {
#pragma unroll
      for (int ai = 0; ai < 2; ++ai)
#pragma unroll
        for (int m = 0; m < 4; ++m) {
          const int rl = ai * 128 + wr * 64 + m * 16 + fr;
          u16* mrow = mbuf + (size_t)(u.pm * 256 + rl) * 1024 + u.pn * 256 + cl0;
#pragma unroll
          for (int bj = 0; bj < 2; ++bj) {
            const uint4 g = *(const uint4*)(gs + rl * 256 + cl0 + bj * 128);
            const pg8::f32x4 a0 = acc[ai][bj][m][0], a1 = acc[ai][bj][m][1];
            float r0 = bflo(g.x) * a0[0], r1 = bfhi(g.x) * a0[1], r2 = bflo(g.y) * a0[2], r3 = bfhi(g.y) * a0[3];
            float r4 = bflo(g.z) * a1[0], r5 = bfhi(g.z) * a1[1], r6 = bflo(g.w) * a1[2], r7 = bfhi(g.w) * a1[3];
            if (u.nb != 0) {
              const uint4 o = *(const uint4*)(mrow + bj * 128);
              r0 += bflo(o.x); r1 += bfhi(o.x); r2 += bflo(o.y); r3 += bfhi(o.y);
              r4 += bflo(o.z); r5 += bfhi(o.z); r6 += bflo(o.w); r7 += bfhi(o.w);
            }
            *(uint4*)(mrow + bj * 128) = make_uint4(pk2(r0, r1), pk2(r2, r3), pk2(r4, r5), pk2(r6, r7));
          }
        }
    }
  }
};
struct SchedP3 {
  pg8::StaticOrder tiles;
  const char *u, *wg, *z, *wbr;
  DI bool next(int i, pg8::SubUnit& su) const {
    const int ti = i / 6, sub = i - ti * 6;
    pg8::Unit t;
    if (!tiles.next(ti, t)) return false;
    su.pm = t.pm; su.pn = t.pn; su.nb = sub >> 1; su.kind = sub & 1;
    if (su.kind == 0) {
      su.a = u + (size_t)t.pm * 256 * 1024 * 2;
      su.b = wg + (size_t)(su.nb * 1024 + t.pn * 256) * 1024 * 2;
    } else {
      const int slotcol = (su.nb == 0) ? 0 : (su.nb == 1 ? 512 : 5 * 512);
      su.a = z + ((size_t)t.pm * 256 * ZC + slotcol) * 2;
      su.b = wbr + (size_t)(su.nb * 1024 + t.pn * 256) * 512 * 2;
    }
    return true;
  }
};

DI void phase3(const Params& p, int l, char* lds) {
  EpiP3 E;
  E.gs = (u16*)(p.ws + OFF_GS) + (size_t)blockIdx.x * 65536;
  E.mbuf = (u16*)(p.ws + OFF_M);
  E.biasg = (const float*)(p.ws + OFF_BIASP) + l * NIN + 4608;
  SchedP3 S;
  S.tiles.init(l == 0 ? NTOK : T_LAT, 1024, gridDim.x, blockIdx.x);
  S.u = p.ws + OFF_U;
  S.wg = p.ws + OFF_WTIN + ((size_t)l * NIN + 4608) * 1024 * 2;
  S.z = p.ws + OFF_Z;
  S.wbr = p.ws + OFF_WTBR + (size_t)l * 3 * 1024 * 512 * 2;
  pg8::Kinds kd;
  kd.lda0 = 1024; kd.ldb0 = 1024; kd.nt0 = 16;
  kd.lda1 = ZC;   kd.ldb1 = 512;  kd.nt1 = 8;
  pg8::gemm_stream2<EpiP3, SchedP3>((PG8_LAS unsigned char*)lds, kd, S, E);
}

struct EpiP4 {
  static constexpr bool PERM = false, AFTER_DRAIN = false;
  const float *x, *ctx, *mod; float *out, *rctx; int l;
  DI void operator()(const pg8::f32x4 (&acc)[2][2][4][2], const pg8::Unit& u, int wr, int wc, int fr, int fq) const {
    asm volatile("" : "+v"(fr), "+v"(fq));
    const int c0 = u.pn * 256 + wc * 32 + 4 * fq;
    const int tok0 = u.pm * 256;
    const int bidx = tok0 < T_LAT ? (tok0 >> 13) : 8;
    const float* gate = mod + (size_t)(l * 9 + bidx) * 3072 + 2048 + c0;
    pg8::f32x4 gv[2][2];
#pragma unroll
    for (int bj = 0; bj < 2; ++bj)
#pragma unroll
      for (int n = 0; n < 2; ++n) gv[bj][n] = *(const pg8::f32x4*)(gate + bj * 128 + n * 16);
#pragma unroll
    for (int ai = 0; ai < 2; ++ai)
#pragma unroll
      for (int m = 0; m < 4; ++m) {
        const int tok = tok0 + ai * 128 + wr * 64 + m * 16 + fr;
        const float* xr; float* dst;
        if (tok < T_LAT) { xr = (l == 0 ? x : out) + (size_t)tok * 1024 + c0; dst = out + (size_t)tok * 1024 + c0; }
        else { xr = ctx + (size_t)(tok - T_LAT) * 1024 + c0; dst = rctx + (size_t)(tok - T_LAT) * 1024 + c0; }
#pragma unroll
        for (int bj = 0; bj < 2; ++bj)
#pragma unroll
          for (int n = 0; n < 2; ++n) {
            const pg8::f32x4 xv = *(const pg8::f32x4*)(xr + bj * 128 + n * 16);
            *(pg8::f32x4*)(dst + bj * 128 + n * 16) = xv * ALPHA_DN + gv[bj][n] * acc[ai][bj][m][n];
          }
      }
  }
};
DI void phase4a(const Params& p, int l, char* lds) {
  EpiP4 E;
  E.x = p.x; E.ctx = p.ctx; E.mod = (const float*)(p.ws + OFF_MOD); E.out = p.out; E.rctx = (float*)(p.ws + OFF_RCTX); E.l = l;
  pg8::StaticOrder S;
  S.init(l == 0 ? NTOK : T_LAT, 1024, gridDim.x, blockIdx.x);
  pg8::gemm_phase<EpiP4, pg8::StaticOrder>((PG8_LAS unsigned char*)lds, (const u16*)(p.ws + OFF_M), 1024,
                                          (const u16*)(p.ws + OFF_WTOUT) + (size_t)l * 1024 * 1024, 1024, 1024, S, E);
}
DI void phase4b(const Params& p, int l) {
  const float* mod = (const float*)(p.ws + OFF_MOD);
  float* rctx = (float*)(p.ws + OFF_RCTX);
  u16* u = (u16*)(p.ws + OFF_U);
  const int tid = thr(), lane = tid & 63, wave = tid >> 6;
  const int nrows = (l == 0) ? NTOK : T_LAT;
  float4 lg[4], lb[4];
#pragma unroll
  for (int i = 0; i < 4; ++i) { lg[i] = *(const float4*)(p.ln_g + l * 1024 + i * 256 + lane * 4); lb[i] = *(const float4*)(p.ln_b + l * 1024 + i * 256 + lane * 4); }
  for (int row = blockIdx.x * 8 + wave; row < nrows; row += gridDim.x * 8) {
    float* src = row < T_LAT ? p.out + (size_t)row * 1024 : rctx + (size_t)(row - T_LAT) * 1024;
    float4 v[4];
#pragma unroll
    for (int i = 0; i < 4; ++i) v[i] = *(const float4*)(src + i * 256 + lane * 4);
    float s = 0.f;
#pragma unroll
    for (int i = 0; i < 4; ++i) s += (v[i].x + v[i].y) + (v[i].z + v[i].w);
#pragma unroll
    for (int o = 32; o > 0; o >>= 1) s += __shfl_xor(s, o);
    const float mean = s * (1.f / 1024.f);
    float ss = 0.f;
#pragma unroll
    for (int i = 0; i < 4; ++i) { v[i].x -= mean; v[i].y -= mean; v[i].z -= mean; v[i].w -= mean; ss += (v[i].x * v[i].x + v[i].y * v[i].y) + (v[i].z * v[i].z + v[i].w * v[i].w); }
#pragma unroll
    for (int o = 32; o > 0; o >>= 1) ss += __shfl_xor(ss, o);
    const float rstd = rsqrtf(ss * (1.f / 1024.f) + 1e-5f);
    const int bidx = row < T_LAT ? (row >> 13) : 8;
    const float* m1 = mod + (size_t)(9 + bidx) * 3072;
#pragma unroll
    for (int i = 0; i < 4; ++i) {
      const int ch = i * 256 + lane * 4;
      float4 y;
      y.x = v[i].x * rstd * lg[i].x + lb[i].x; y.y = v[i].y * rstd * lg[i].y + lb[i].y;
      y.z = v[i].z * rstd * lg[i].z + lb[i].z; y.w = v[i].w * rstd * lg[i].w + lb[i].w;
      if (l == 0) {
        if (row < T_LAT) *(float4*)(p.out + (size_t)row * 1024 + ch) = y;
        const float4 sh = *(const float4*)(m1 + ch), scl = *(const float4*)(m1 + 1024 + ch);
        uint2 w;
        w.x = pk2(y.x * (1.f + scl.x) + sh.x, y.y * (1.f + scl.y) + sh.y);
        w.y = pk2(y.z * (1.f + scl.z) + sh.z, y.w * (1.f + scl.w) + sh.w);
        *(uint2*)(u + (size_t)row * 1024 + ch) = w;
      } else {
        *(float4*)(p.out + (size_t)row * 1024 + ch) = y;
      }
    }
  }
}

DI void grid_barrier(unsigned* ctr, unsigned target) {
  asm volatile("s_waitcnt vmcnt(0) lgkmcnt(0)" ::: "memory");
  __syncthreads();
  if (threadIdx.x == 0) {
    __builtin_amdgcn_fence(__ATOMIC_RELEASE, "agent");
    asm volatile("s_waitcnt vmcnt(0)" ::: "memory");
    __hip_atomic_fetch_add(ctr, 1u, __ATOMIC_RELAXED, __HIP_MEMORY_SCOPE_AGENT);
    while (__hip_atomic_load(ctr, __ATOMIC_RELAXED, __HIP_MEMORY_SCOPE_AGENT) < target) __builtin_amdgcn_s_sleep(2);
    __builtin_amdgcn_fence(__ATOMIC_ACQUIRE, "agent");
    asm volatile("s_waitcnt vmcnt(0)" ::: "memory");
  }
  __syncthreads();
}

__global__ void __launch_bounds__(NTHREADS) hybrid_fwd(Params p) {
  extern __shared__ __attribute__((aligned(16))) char lds[];
  cg::grid_group grid = cg::this_grid();
#define OPQ(q_) Params q_ = p; { size_t o_ = 0; asm volatile("" : "+s"(o_)); q_.ws = p.ws + o_; q_.out = p.out + o_; }
  { OPQ(q) phase0(q, lds); }
  grid.sync();
  unsigned* bar_ = (unsigned*)(p.ws + OFF_BAR); unsigned bt_ = 0;
#define GBAR() do { bt_ += gridDim.x; grid_barrier(bar_, bt_); } while (0)
  { OPQ(q) phase0b(q); }
  GBAR();
#define LAYER(l)                          \
  { OPQ(q) phase1(q, l, lds); }           \
  GBAR();                            \
  { OPQ(q) phase2(q, l, lds); }           \
  GBAR();                            \
  { OPQ(q) phase2b(q, l, lds); }          \
  GBAR();                            \
  { OPQ(q) phase3(q, l, lds); }           \
  GBAR();                            \
  { OPQ(q) phase4a(q, l, lds); }          \
  GBAR();                            \
  { OPQ(q) phase4b(q, l); }
  LAYER(0)
  GBAR();
  LAYER(1)
#undef LAYER
#undef OPQ
#undef GBAR
}

extern "C" void kernel_launch(void* const* d_in, const int* in_sizes, int n_in, void* d_out, int out_size, void* d_ws,
                              size_t ws_size, hipStream_t stream) {
  static int grid_blocks = 0;
  if (!grid_blocks) {
    static const int expect[24] = {67108864, 8192, 2097152, 1024, 6291456, 6144, 15728640, 15360, 1024, 1024, 131072, 1024,
                                   4096, 1024, 131072, 2048, 131072, 2048, 2048, 7440, 3145728, 2097152, 2048, 2048};
    bool ok = (n_in == 24) && (out_size == 67108864);
    for (int i = 0; ok && i < 24; ++i) ok = (in_sizes[i] == expect[i]);
    if (!ok || ws_size < WS_END) {
      fprintf(stderr, "kernel_launch: unexpected n_in %d or ws_size %zu (< %zu)\n", n_in, ws_size, (size_t)WS_END);
      grid_blocks = -1;
      return;
    }
    int dev = 0, cus = 0, per_cu = 0;
    hipGetDevice(&dev);
    hipDeviceGetAttribute(&cus, hipDeviceAttributeMultiprocessorCount, dev);
    hipFuncSetAttribute((const void*)hybrid_fwd, hipFuncAttributeMaxDynamicSharedMemorySize, LDS_BYTES);
    hipOccupancyMaxActiveBlocksPerMultiprocessor(&per_cu, (const void*)hybrid_fwd, NTHREADS, LDS_BYTES);
    if (per_cu < 1) per_cu = 1;
    grid_blocks = cus * per_cu;
    (void)hipGetLastError();
  }
  if (grid_blocks < 0) return;
  Params p{};
  const float** pp = (const float**)&p;
  for (int i = 0; i < 24; ++i) pp[i] = (const float*)d_in[i];
  p.out = (float*)d_out;
  p.ws = (char*)d_ws;
  void* args[] = {&p};
  hipError_t e = hipLaunchCooperativeKernel((const void*)hybrid_fwd, dim3(grid_blocks), dim3(NTHREADS), args, LDS_BYTES, stream);
  if (e != hipSuccess) fprintf(stderr, "cooperative launch failed: %s (grid %d)\n", hipGetErrorString(e), grid_blocks);
}
```

```cpp
#include <hip/hip_runtime.h>
#include <hip/hip_cooperative_groups.h>
#include <cstdio>
namespace cg = cooperative_groups;


typedef unsigned short u16;
using bf16x8 = __attribute__((ext_vector_type(8))) short;
using f32x16 = __attribute__((ext_vector_type(16))) float;
#define DI __device__ __forceinline__
#define MFMA(a, b, c) __builtin_amdgcn_mfma_f32_32x32x16_bf16((a), (b), (c), 0, 0, 0)

constexpr int T_LAT = 65536;
constexpr int T_CTX = 2048;
constexpr int NTOK = T_LAT + T_CTX;
constexpr int DM = 1024;
constexpr int NIN = 7680;
constexpr int ZC = 4096;
constexpr int NTHREADS = 512;
constexpr int LDS_BYTES = 147456;
constexpr float ALPHA_DN = 1.4142135623730951f;

constexpr size_t OFF_WTIN = 0;
constexpr size_t OFF_WTBR = OFF_WTIN + 2ull * 7680 * 1024 * 2;
constexpr size_t OFF_WTOUT = OFF_WTBR + 2ull * 3 * 1024 * 512 * 2;
constexpr size_t OFF_LRUW = OFF_WTOUT + 2ull * 1024 * 1024 * 2;
constexpr size_t OFF_WSB = OFF_LRUW + 2ull * 2 * 2 * 8 * 4096 * 2;
constexpr size_t OFF_BIASP = OFF_WSB + 2ull * 4 * 128 * 128 * 2;
constexpr size_t OFF_MOD = OFF_BIASP + 65536;
constexpr size_t OFF_ROPE = OFF_MOD + 262144;
constexpr size_t OFF_AGG = OFF_ROPE + 16384;
constexpr size_t AGG_HALF = 528ull * 2 * 512 * 4;
constexpr size_t OFF_U = OFF_AGG + 2 * AGG_HALF;
constexpr size_t OFF_M = OFF_U + (size_t)NTOK * 1024 * 2;
constexpr size_t OFF_Z = OFF_M + (size_t)NTOK * 1024 * 2;
constexpr size_t OFF_VTL = OFF_Z + (size_t)NTOK * ZC * 2;
constexpr size_t OFF_VTC = OFF_VTL + 8ull * 512 * 8192 * 2;
constexpr size_t OFF_GS = OFF_VTC + 8ull * 512 * 256 * 2;
constexpr size_t OFF_RCTX = OFF_GS + 256ull * 256 * 256 * 2;
constexpr size_t OFF_BAR = OFF_RCTX + (size_t)T_CTX * 1024 * 4;
constexpr size_t WS_END = OFF_BAR + 256;

struct Params {
  const float *x, *c, *ctx, *c_ctx, *w_ada, *b_ada, *w_in, *b_in, *sgu_ln_g, *sgu_ln_b, *w_s, *b_s,
      *conv_w, *conv_b, *lru_wa, *lru_ba, *lru_wx, *lru_bx, *lru_lam, *rpb, *w_br, *w_out, *ln_g, *ln_b;
  float* out;
  char* ws;
};

DI unsigned pk2(float a, float b) {
  typedef __bf16 bf2 __attribute__((ext_vector_type(2)));
  typedef float f2 __attribute__((ext_vector_type(2)));
  f2 v = {a, b};
  bf2 r = __builtin_convertvector(v, bf2);
  return __builtin_bit_cast(unsigned, r);
}
DI u16 f2bf(float a) { return (u16)(pk2(a, 0.f) & 0xffffu); }
DI float bflo(unsigned v) { return __uint_as_float(v << 16); }
DI float bfhi(unsigned v) { return __uint_as_float(v & 0xffff0000u); }
DI float bf2f(u16 v) { return __uint_as_float(((unsigned)v) << 16); }
DI int thr() { int t = threadIdx.x; asm volatile("" : "+v"(t)); return t; }
DI int crow(int i, int hh) { return (i & 3) + 8 * (i >> 2) + 4 * hh; }
DI float sigmoidf_(float x) { return __builtin_amdgcn_rcpf(1.f + __expf(-x)); }
DI float siluf_(float x) { return x * __builtin_amdgcn_rcpf(1.f + __expf(-x)); }
DI float geluf_(float x) { return 0.5f * x * (1.f + erff(x * 0.70710678118654752f)); }
DI float gelu_as_(float v) {
  const float av = fabsf(v), t = __builtin_amdgcn_rcpf(av * 0.2316418882f + 1.0f);
  float q = t * 0.5307027145f + (-0.7265760135f); q = q * t + 0.7107068705f; q = q * t + (-0.142248368f); q = q * t + 0.127414796f; q = q * t;
  const float e = __builtin_amdgcn_exp2f((v * v) * (-0.72134752044f));
  const float m = v * (q * e);
  return v < 0.f ? m : v - m;
}

DI void gload16_asm(bf16x8& d, const void* p) { asm volatile("global_load_dwordx4 %0, %1, off" : "=v"(d) : "v"(p) : "memory"); }
DI void vm_wait0_4(bf16x8& a, bf16x8& b, bf16x8& c, bf16x8& d) {
  asm volatile("s_waitcnt vmcnt(0)" : "+v"(a), "+v"(b), "+v"(c), "+v"(d) : : "memory");
}

template <int WGP, int WGQ, int WP, int WQ, int BK>
DI void gemm_core(f32x16 (&acc)[WP][WQ], const u16* __restrict__ Pg, int ldp, const u16* __restrict__ Qg, int ldq,
                  int K, char* lds) {
  constexpr int BP = WGP * WP * 32, BQ = WGQ * WQ * 32, CPR = BK / 8, ROWB = BK * 2;
  constexpr int RPL = 16 / CPR, RPP = NTHREADS / CPR;
  constexpr int NPP = BP / RPP, NQP = (BQ + RPP - 1) / RPP;
  constexpr bool QPART = (BQ % RPP) != 0;
  constexpr int STG = (BP + NQP * RPP) * ROWB;
  static_assert(BP % RPP == 0, "BP");
  static_assert(!QPART || NQP == 1, "QPART");
  static_assert(2 * STG <= LDS_BYTES, "LDS");
  const int tid = thr(), lane = tid & 63, wave = tid >> 6, n = lane & 31, hh = lane >> 5;
  const int wp = wave / WGQ, wq = wave % WGQ;
  const int lrow = tid / CPR, ccl = tid % CPR;
  const int ccg = ccl ^ ((lrow / RPL) % CPR);
  const int lrowq = QPART ? (lrow % BQ) : lrow;
  const unsigned voffP = (unsigned)(lrow * ldp + ccg * 8) * 2u, voffQ = (unsigned)(lrowq * ldq + ccg * 8) * 2u;
  const char* Pb = (const char*)Pg;
  const char* Qb = (const char*)Qg;
#define GC_STAGE(kt_, buf_)                                                                                  \
  {                                                                                                          \
    const int ko_ = (kt_) * BK * 2;                                                                          \
    char* nb_ = lds + (buf_) * STG + tid * 16;                                                               \
    _Pragma("unroll") for (int i = 0; i < NPP; ++i)                                                          \
        __builtin_amdgcn_global_load_lds((const unsigned*)(Pb + ((size_t)i * RPP * ldp * 2 + ko_) + voffP), \
                                         (__attribute__((address_space(3))) unsigned*)(nb_ + i * RPP * ROWB), 16, 0, 0); \
    _Pragma("unroll") for (int i = 0; i < NQP; ++i)                                                          \
        __builtin_amdgcn_global_load_lds((const unsigned*)(Qb + ((size_t)i * RPP * ldq * 2 + ko_) + voffQ), \
                                         (__attribute__((address_space(3))) unsigned*)(nb_ + (BP + i * RPP) * ROWB), 16, 0, 0); \
  }
  GC_STAGE(0, 0);
  __syncthreads();
  const int nk = K / BK;
  const int swz = (n / RPL) % CPR;
  for (int kt = 0; kt < nk; ++kt) {
    if (kt + 1 < nk) GC_STAGE(kt + 1, (kt + 1) & 1);
    const char* base = lds + (kt & 1) * STG;
#pragma unroll
    for (int ks = 0; ks < BK / 16; ++ks) {
      bf16x8 af[WP], bq[WQ];
      const int co = (((ks * 2 + hh) ^ swz) * 16);
#pragma unroll
      for (int pi = 0; pi < WP; ++pi) af[pi] = *(const bf16x8*)(base + ((wp * WP + pi) * 32 + n) * ROWB + co);
#pragma unroll
      for (int qi = 0; qi < WQ; ++qi) bq[qi] = *(const bf16x8*)(base + (BP + (wq * WQ + qi) * 32 + n) * ROWB + co);
#pragma unroll
      for (int pi = 0; pi < WP; ++pi)
#pragma unroll
        for (int qi = 0; qi < WQ; ++qi) acc[pi][qi] = MFMA(af[pi], bq[qi], acc[pi][qi]);
    }
    __syncthreads();
  }
#undef GC_STAGE
}

namespace pg8 {
#define PG8_LAS __attribute__((address_space(3)))
typedef float f32x4 __attribute__((ext_vector_type(4)));
constexpr int BM = 256, BK = 64, HALF = 128, HTB = HALF * BK * 2, NXCD = 8, WGM = 8;
DI int lds_byte(int r, int c) { const int st = (r >> 4) * 2 + (c >> 5), rr = r & 15, cc = c & 31, ob = rr * 64 + cc * 2; return st * 1024 + (ob ^ (((ob >> 9) & 1) << 5)); }
DI void stage_rc(int b, int& R, int& C) { const int st = b / 1024, sb = b % 1024, swz = sb ^ (((sb >> 9) & 1) << 5); R = (st >> 1) * 16 + swz / 64; C = (st & 1) * 32 + (swz % 64) / 2; }
DI int perm32(int rho) { const int n = rho >> 4, i = rho & 15; return 8 * (i >> 2) + 4 * n + (i & 3); }
struct Unit { int pm, pn; };
struct StaticOrder {
  int nM, nN, nwg, G, c;
  DI void init(int M, int N, int G_, int c_) { nM = M / BM; nN = N / BM; nwg = nM * nN; G = G_; c = c_; }
  DI bool next(int i, Unit& u) const {
    const long L = (long)i * G + c; if (L >= nwg) return false;
    int wgid = (int)L; { const int q = nwg / NXCD, r = nwg % NXCD, xcd = wgid % NXCD, off = wgid / NXCD; wgid = (xcd < r ? xcd * (q + 1) : r * (q + 1) + (xcd - r) * q) + off; }
    const int nig = WGM * nN, gid = wgid / nig, fm = gid * WGM, gsz = (nM - fm) < WGM ? (nM - fm) : WGM;
    u.pm = fm + ((wgid % nig) % gsz); u.pn = (wgid % nig) / gsz; return true;
  }
};
template <class Epi, class Sched>
DI void gemm_phase(PG8_LAS unsigned char* lds, const u16* Ag, int lda, const u16* Btg, int ldb, int K, const Sched& S, const Epi& E) {
  const int tid = threadIdx.x, wid = __builtin_amdgcn_readfirstlane(tid >> 6), lane = tid & 63, wr = wid >> 2, wc = wid & 3, fr = lane & 15, fq = lane >> 4;
  const int nt = K / BK;
  unsigned voffA[2], voffB[2];
#pragma unroll
  for (int i = 0; i < 2; ++i) { int R, C; stage_rc(tid * 16 + i * 8192, R, C); const int Rb = Epi::PERM ? ((R & ~31) + perm32(R & 31)) : R;
    voffA[i] = (unsigned)(R * lda + C) * 2u; voffB[i] = (unsigned)(Rb * ldb + C) * 2u; }
  const size_t kstep = (size_t)(BK * 2);
  const size_t hstepA = (size_t)HALF * lda * 2, hstepB = (size_t)HALF * ldb * 2;
  const size_t tstepA = 2 * hstepA, tstepB = 2 * hstepB;
  const unsigned ldsw = (unsigned)wid * 1024u;
  const int aoff = lds_byte(wr * 64 + fr, fq * 8), boff = lds_byte(wc * 32 + fr, fq * 8);
#define PG8_SA(b, h) (((b) * 2 + (h)) * HTB)
#define PG8_SB(b, h) ((4 + (b) * 2 + (h)) * HTB)
#define PG8_STAGE(bufoff, gbase, voff) do { _Pragma("unroll") for (int _i = 0; _i < 2; ++_i) \
    __builtin_amdgcn_global_load_lds((const unsigned*)((const char*)(gbase) + (voff)[_i]), (PG8_LAS unsigned*)(lds + (bufoff) + ldsw + _i * 8192), 16, 0, 0); } while (0)
#define PG8_LDA(dst, b, h) do { _Pragma("unroll") for (int m = 0; m < 4; ++m) _Pragma("unroll") for (int k = 0; k < 2; ++k) dst[m][k] = *(const PG8_LAS bf16x8*)(lds + PG8_SA(b, h) + aoff + m * 2048 + k * 1024); } while (0)
#define PG8_LDB(dst, b, h) do { _Pragma("unroll") for (int n = 0; n < 2; ++n) _Pragma("unroll") for (int k = 0; k < 2; ++k) dst[n][k] = *(const PG8_LAS bf16x8*)(lds + PG8_SB(b, h) + boff + n * 2048 + k * 1024); } while (0)
#define PG8_MMA(ai, bj, At, Bt) do { __builtin_amdgcn_s_setprio(1); _Pragma("unroll") for (int m = 0; m < 4; ++m) _Pragma("unroll") for (int n = 0; n < 2; ++n) _Pragma("unroll") for (int k = 0; k < 2; ++k) \
    acc[ai][bj][m][n] = __builtin_amdgcn_mfma_f32_16x16x32_bf16(Bt[n][k], At[m][k], acc[ai][bj][m][n], 0, 0, 0); __builtin_amdgcn_s_setprio(0); } while (0)
#define PG8_WAIT_V(n) asm volatile("s_waitcnt vmcnt(" #n ")" ::: "memory")
#define PG8_WAIT_L(n) asm volatile("s_waitcnt lgkmcnt(" #n ")" ::: "memory")
#define PG8_BAR __builtin_amdgcn_s_barrier()
#define PG8_SCHED __builtin_amdgcn_sched_barrier(0)
  Unit cur, nxt; int ui = 0;
  if (!S.next(0, cur)) return;
  f32x4 acc[2][2][4][2];
#pragma unroll
  for (int a = 0; a < 2; ++a)
#pragma unroll
    for (int b = 0; b < 2; ++b)
#pragma unroll
      for (int m = 0; m < 4; ++m)
#pragma unroll
        for (int n = 0; n < 2; ++n) acc[a][b][m][n] = (f32x4){0.f, 0.f, 0.f, 0.f};
  bf16x8 At[4][2], B0[2][2], B1[2][2];
  const char* cA = (const char*)Ag + (size_t)cur.pm * tstepA; const char* cB = (const char*)Btg + (size_t)cur.pn * tstepB;
  PG8_STAGE(PG8_SB(0, 0), cB, voffB); PG8_STAGE(PG8_SA(0, 0), cA, voffA); PG8_STAGE(PG8_SB(0, 1), cB + hstepB, voffB); PG8_STAGE(PG8_SA(0, 1), cA + hstepA, voffA);
  if (wr == 1) PG8_BAR;
  PG8_WAIT_V(4); PG8_BAR;
  PG8_STAGE(PG8_SB(1, 0), cB + kstep, voffB); PG8_STAGE(PG8_SA(1, 0), cA + kstep, voffA); PG8_STAGE(PG8_SB(1, 1), cB + hstepB + kstep, voffB);
  PG8_WAIT_V(6); PG8_BAR;
  for (;;) {
    const bool has_next = S.next(ui + 1, nxt);
    const char* nA = has_next ? (const char*)Ag + (size_t)nxt.pm * tstepA : cA; const char* nB = has_next ? (const char*)Btg + (size_t)nxt.pn * tstepB : cB;
    for (int t = 0; t < nt; t += 2) {
      const bool last = (t == nt - 2);
      const char* a1 = cA + (size_t)(t + 1) * kstep;
      const char* a2 = last ? nA : cA + (size_t)(t + 2) * kstep; const char* b2 = last ? nB : cB + (size_t)(t + 2) * kstep;
      const char* a3 = a2 + kstep; const char* b3 = b2 + kstep;
      PG8_LDB(B0, 0, 0); PG8_SCHED; PG8_LDA(At, 0, 0); PG8_STAGE(PG8_SA(1, 1), a1 + hstepA, voffA);
      PG8_WAIT_L(8); PG8_BAR; PG8_WAIT_L(0); PG8_MMA(0, 0, At, B0); PG8_BAR; PG8_SCHED;
      PG8_LDB(B1, 0, 1); PG8_STAGE(PG8_SB(0, 0), b2, voffB);
      PG8_BAR; PG8_WAIT_L(0); PG8_MMA(0, 1, At, B1); PG8_BAR;
      PG8_LDA(At, 0, 1); PG8_STAGE(PG8_SA(0, 0), a2, voffA);
      PG8_BAR; PG8_WAIT_L(0); PG8_MMA(1, 0, At, B0); PG8_BAR; PG8_SCHED;
      PG8_STAGE(PG8_SB(0, 1), b2 + hstepB, voffB);
      PG8_WAIT_V(6); PG8_BAR; PG8_MMA(1, 1, At, B1); PG8_BAR;
      PG8_LDB(B0, 1, 0); PG8_SCHED; PG8_LDA(At, 1, 0); PG8_STAGE(PG8_SA(0, 1), a2 + hstepA, voffA);
      PG8_WAIT_L(8); PG8_BAR; PG8_WAIT_L(0); PG8_MMA(0, 0, At, B0); PG8_BAR; PG8_SCHED;
      PG8_LDB(B1, 1, 1); PG8_STAGE(PG8_SB(1, 0), b3, voffB);
      PG8_BAR; PG8_WAIT_L(0); PG8_MMA(0, 1, At, B1); PG8_BAR;
      PG8_LDA(At, 1, 1); PG8_STAGE(PG8_SA(1, 0), a3, voffA);
      PG8_BAR; PG8_WAIT_L(0); PG8_MMA(1, 0, At, B0); PG8_BAR; PG8_SCHED;
      PG8_STAGE(PG8_SB(1, 1), b3 + hstepB, voffB);
      PG8_WAIT_V(6); PG8_BAR; PG8_MMA(1, 1, At, B1); PG8_BAR;
    }
    E(acc, cur, wr, wc, fr, fq);
    if (!has_next) break;
#pragma unroll
    for (int a = 0; a < 2; ++a)
#pragma unroll
      for (int b = 0; b < 2; ++b)
#pragma unroll
        for (int m = 0; m < 4; ++m)
#pragma unroll
          for (int n = 0; n < 2; ++n) acc[a][b][m][n] = (f32x4){0.f, 0.f, 0.f, 0.f};
    cur = nxt; cA = nA; cB = nB; ++ui;
  }
  PG8_WAIT_V(0);
  if (wr == 0) PG8_BAR;
  PG8_BAR;
#undef PG8_SA
#undef PG8_SB
#undef PG8_STAGE
#undef PG8_LDA
#undef PG8_LDB
#undef PG8_MMA
#undef PG8_WAIT_V
#undef PG8_WAIT_L
#undef PG8_BAR
#undef PG8_SCHED
}

struct SubUnit { const char* a; const char* b; int kind, pm, pn, nb; };
struct Kinds { int lda0, lda1, ldb0, ldb1, nt0, nt1; };
template <class Epi, class Sched>
DI void gemm_stream2(PG8_LAS unsigned char* lds, const Kinds kd, const Sched& S, const Epi& E) {
  const int tid = threadIdx.x, wid = __builtin_amdgcn_readfirstlane(tid >> 6), lane = tid & 63, wr = wid >> 2, wc = wid & 3, fr = lane & 15, fq = lane >> 4;
  unsigned sRA[2], sRB[2], sC2[2];
#pragma unroll
  for (int i = 0; i < 2; ++i) { int R, C; stage_rc(tid * 16 + i * 8192, R, C); sRA[i] = (unsigned)R; sRB[i] = (unsigned)(Epi::PERM ? ((R & ~31) + perm32(R & 31)) : R); sC2[i] = (unsigned)C * 2u; }
  const size_t kstep = (size_t)(BK * 2);
  const unsigned ldsw = (unsigned)wid * 1024u;
  const int aoff = lds_byte(wr * 64 + fr, fq * 8), boff = lds_byte(wc * 32 + fr, fq * 8);
#define PG8_SA(b, h) (((b) * 2 + (h)) * HTB)
#define PG8_SB(b, h) ((4 + (b) * 2 + (h)) * HTB)
#define PG8_STAGE(bufoff, gbase, rr_, ld2_) do { \
    __builtin_amdgcn_global_load_lds((const unsigned*)((const char*)(gbase) + (__umul24((rr_)[0], (unsigned)(ld2_)) + sC2[0])), (PG8_LAS unsigned*)(lds + (bufoff) + ldsw), 16, 0, 0); \
    __builtin_amdgcn_global_load_lds((const unsigned*)((const char*)(gbase) + (__umul24((rr_)[1], (unsigned)(ld2_)) + sC2[1])), (PG8_LAS unsigned*)(lds + (bufoff) + ldsw + 8192), 16, 0, 0); } while (0)
#define PG8_LDA(dst, b, h) do { _Pragma("unroll") for (int m = 0; m < 4; ++m) _Pragma("unroll") for (int k = 0; k < 2; ++k) dst[m][k] = *(const PG8_LAS bf16x8*)(lds + PG8_SA(b, h) + aoff + m * 2048 + k * 1024); } while (0)
#define PG8_LDB(dst, b, h) do { _Pragma("unroll") for (int n = 0; n < 2; ++n) _Pragma("unroll") for (int k = 0; k < 2; ++k) dst[n][k] = *(const PG8_LAS bf16x8*)(lds + PG8_SB(b, h) + boff + n * 2048 + k * 1024); } while (0)
#define PG8_MMA(ai, bj, At, Bt) do { __builtin_amdgcn_s_setprio(1); _Pragma("unroll") for (int m = 0; m < 4; ++m) _Pragma("unroll") for (int n = 0; n < 2; ++n) _Pragma("unroll") for (int k = 0; k < 2; ++k) \
    acc[ai][bj][m][n] = __builtin_amdgcn_mfma_f32_16x16x32_bf16(Bt[n][k], At[m][k], acc[ai][bj][m][n], 0, 0, 0); __builtin_amdgcn_s_setprio(0); } while (0)
#define PG8_WAIT_V(n) asm volatile("s_waitcnt vmcnt(" #n ")" ::: "memory")
#define PG8_WAIT_L(n) asm volatile("s_waitcnt lgkmcnt(" #n ")" ::: "memory")
#define PG8_BAR __builtin_amdgcn_s_barrier()
#define PG8_SCHED __builtin_amdgcn_sched_barrier(0)
  SubUnit cur, nxt; int ui = 0;
  if (!S.next(0, cur)) return;
  f32x4 acc[2][2][4][2];
#pragma unroll
  for (int a = 0; a < 2; ++a)
#pragma unroll
    for (int b = 0; b < 2; ++b)
#pragma unroll
      for (int m = 0; m < 4; ++m)
#pragma unroll
        for (int n = 0; n < 2; ++n) acc[a][b][m][n] = (f32x4){0.f, 0.f, 0.f, 0.f};
  bf16x8 At[4][2], B0[2][2], B1[2][2];
  const char* cA = cur.a; const char* cB = cur.b;
  int cla2 = (cur.kind ? kd.lda1 : kd.lda0) * 2, clb2 = (cur.kind ? kd.ldb1 : kd.ldb0) * 2;
  size_t chA = (size_t)HALF * cla2, chB = (size_t)HALF * clb2;
  PG8_STAGE(PG8_SB(0, 0), cB, sRB, clb2); PG8_STAGE(PG8_SA(0, 0), cA, sRA, cla2); PG8_STAGE(PG8_SB(0, 1), cB + chB, sRB, clb2); PG8_STAGE(PG8_SA(0, 1), cA + chA, sRA, cla2);
  if (wr == 1) PG8_BAR;
  PG8_WAIT_V(4); PG8_BAR;
  PG8_STAGE(PG8_SB(1, 0), cB + kstep, sRB, clb2); PG8_STAGE(PG8_SA(1, 0), cA + kstep, sRA, cla2); PG8_STAGE(PG8_SB(1, 1), cB + chB + kstep, sRB, clb2);
  PG8_WAIT_V(6); PG8_BAR;
  for (;;) {
    const bool has_next = S.next(ui + 1, nxt);
    if (!has_next) nxt = cur;
    const int nt = cur.kind ? kd.nt1 : kd.nt0;
    const int nla2 = (nxt.kind ? kd.lda1 : kd.lda0) * 2, nlb2 = (nxt.kind ? kd.ldb1 : kd.ldb0) * 2;
    const size_t nhA = (size_t)HALF * nla2, nhB = (size_t)HALF * nlb2;
    for (int t = 0; t < nt; t += 2) {
      const bool last = (t == nt - 2);
      const char* a1 = cA + (size_t)(t + 1) * kstep;
      const char* a2 = last ? nxt.a : cA + (size_t)(t + 2) * kstep; const char* b2 = last ? nxt.b : cB + (size_t)(t + 2) * kstep;
      const char* a3 = a2 + kstep; const char* b3 = b2 + kstep;
      const int xla2 = last ? nla2 : cla2, xlb2 = last ? nlb2 : clb2;
      const size_t xhA = last ? nhA : chA, xhB = last ? nhB : chB;
      PG8_LDB(B0, 0, 0); PG8_SCHED; PG8_LDA(At, 0, 0); PG8_STAGE(PG8_SA(1, 1), a1 + chA, sRA, cla2);
      PG8_WAIT_L(8); PG8_BAR; PG8_WAIT_L(0); PG8_MMA(0, 0, At, B0); PG8_BAR; PG8_SCHED;
      PG8_LDB(B1, 0, 1); PG8_STAGE(PG8_SB(0, 0), b2, sRB, xlb2);
      PG8_BAR; PG8_WAIT_L(0); PG8_MMA(0, 1, At, B1); PG8_BAR;
      PG8_LDA(At, 0, 1); PG8_STAGE(PG8_SA(0, 0), a2, sRA, xla2);
      PG8_BAR; PG8_WAIT_L(0); PG8_MMA(1, 0, At, B0); PG8_BAR; PG8_SCHED;
      PG8_STAGE(PG8_SB(0, 1), b2 + xhB, sRB, xlb2);
      PG8_WAIT_V(6); PG8_BAR; PG8_MMA(1, 1, At, B1); PG8_BAR;
      PG8_LDB(B0, 1, 0); PG8_SCHED; PG8_LDA(At, 1, 0); PG8_STAGE(PG8_SA(0, 1), a2 + xhA, sRA, xla2);
      PG8_WAIT_L(8); PG8_BAR; PG8_WAIT_L(0); PG8_MMA(0, 0, At, B0); PG8_BAR; PG8_SCHED;
      PG8_LDB(B1, 1, 1); PG8_STAGE(PG8_SB(1, 0), b3, sRB, xlb2);
      PG8_BAR; PG8_WAIT_L(0); PG8_MMA(0, 1, At, B1); PG8_BAR;
      PG8_LDA(At, 1, 1); PG8_STAGE(PG8_SA(1, 0), a3, sRA, xla2);
      PG8_BAR; PG8_WAIT_L(0); PG8_MMA(1, 0, At, B0); PG8_BAR; PG8_SCHED;
      PG8_STAGE(PG8_SB(1, 1), b3 + xhB, sRB, xlb2);
      PG8_WAIT_V(6); PG8_BAR; PG8_MMA(1, 1, At, B1); PG8_BAR;
    }
    E(acc, cur, wr, wc, fr, fq);
    if (!has_next) break;
#pragma unroll
    for (int a = 0; a < 2; ++a)
#pragma unroll
      for (int b = 0; b < 2; ++b)
#pragma unroll
        for (int m = 0; m < 4; ++m)
#pragma unroll
          for (int n = 0; n < 2; ++n) acc[a][b][m][n] = (f32x4){0.f, 0.f, 0.f, 0.f};
    cur = nxt; cA = cur.a; cB = cur.b; cla2 = nla2; clb2 = nlb2; chA = nhA; chB = nhB; ++ui;
  }
  PG8_WAIT_V(0);
  if (wr == 0) PG8_BAR;
  PG8_BAR;
#undef PG8_SA
#undef PG8_SB
#undef PG8_STAGE
#undef PG8_LDA
#undef PG8_LDB
#undef PG8_MMA
#undef PG8_WAIT_V
#undef PG8_WAIT_L
#undef PG8_BAR
#undef PG8_SCHED
}
}

DI void phase0(const Params& p, char* lds) {
  u16* wtin = (u16*)(p.ws + OFF_WTIN);
  u16* wtbr = (u16*)(p.ws + OFF_WTBR);
  u16* wtout = (u16*)(p.ws + OFF_WTOUT);
  u16* lruw = (u16*)(p.ws + OFF_LRUW);
  const int tid = thr();
  {
    const int gtid0 = blockIdx.x * NTHREADS + tid, gsz0 = gridDim.x * NTHREADS;
    for (int mi = 0; mi < 10; ++mi) {
      const float* src; u16* dst; int K, N;
      if (mi < 2) { src = p.w_in + (size_t)mi * 1024 * NIN; dst = wtin + (size_t)mi * NIN * 1024; K = 1024; N = NIN; }
      else if (mi < 8) { src = p.w_br + (size_t)(mi - 2) * 512 * 1024; dst = wtbr + (size_t)(mi - 2) * 1024 * 512; K = 512; N = 1024; }
      else { src = p.w_out + (size_t)(mi - 8) * 1024 * 1024; dst = wtout + (size_t)(mi - 8) * 1024 * 1024; K = 1024; N = 1024; }
      const int total = N * (K / 8);
      for (int idx = gtid0; idx < total; idx += gsz0) {
        const int nd = idx % N, kc = idx / N;
        int ns = nd;
        if (mi < 2 && nd >= 2560 && nd < 3584) { int w = nd & 31; ns = (nd & ~31) + ((w & 1) << 4) + (w >> 1); }
        const float* sp = src + (size_t)(kc * 8) * N + ns;
        float v[8];
#pragma unroll
        for (int e = 0; e < 8; ++e) v[e] = sp[(size_t)e * N];
        *(uint4*)(dst + (size_t)nd * K + kc * 8) = make_uint4(pk2(v[0], v[1]), pk2(v[2], v[3]), pk2(v[4], v[5]), pk2(v[6], v[7]));
      }
    }
    for (int idx = gtid0; idx < 2 * 2 * 2 * 8 * 64 * 8; idx += gsz0) {
      const int ic = idx & 7, j = (idx >> 3) & 63, h = (idx >> 9) & 7, which = (idx >> 12) & 1, d = (idx >> 13) & 1, l = idx >> 14;
      const float* sp = (which ? p.lru_wx : p.lru_wa) + (size_t)((l * 2 + d) * 8 + h) * 4096 + (ic * 8) * 64 + j;
      float v[8];
#pragma unroll
      for (int e = 0; e < 8; ++e) v[e] = sp[e * 64];
      *(uint4*)(lruw + (size_t)((((l * 2 + d) * 2 + which) * 8) + h) * 4096 + j * 64 + ic * 8) =
          make_uint4(pk2(v[0], v[1]), pk2(v[2], v[3]), pk2(v[4], v[5]), pk2(v[6], v[7]));
    }
  }
  {
    float* mod = (float*)(p.ws + OFF_MOD);
    float* sc = (float*)lds;
    float* red = (float*)(lds + 9 * 1024 * 4);
    for (int it = blockIdx.x; it < 96; it += gridDim.x) {
      const int l = it / 48, col0 = (it % 48) * 64;
      for (int idx = tid; idx < 9 * 1024; idx += NTHREADS) {
        int r = idx >> 10, k = idx & 1023;
        float v = (r < 8) ? p.c[r * 1024 + k] : p.c_ctx[k];
        sc[idx] = v / (1.f + expf(-v));
      }
      __syncthreads();
      const int j = tid & 63, kg = tid >> 6;
      float a[9];
#pragma unroll
      for (int r = 0; r < 9; ++r) a[r] = 0.f;
      for (int k = kg * 128; k < kg * 128 + 128; ++k) {
        float w = p.w_ada[((size_t)l * 1024 + k) * 3072 + col0 + j];
#pragma unroll
        for (int r = 0; r < 9; ++r) a[r] += sc[r * 1024 + k] * w;
      }
#pragma unroll
      for (int r = 0; r < 9; ++r) red[(kg * 9 + r) * 64 + j] = a[r];
      __syncthreads();
      for (int idx = tid; idx < 9 * 64; idx += NTHREADS) {
        int r = idx >> 6, jj = idx & 63;
        float s = p.b_ada[l * 3072 + col0 + jj];
#pragma unroll
        for (int g = 0; g < 8; ++g) s += red[(g * 9 + r) * 64 + jj];
        mod[(size_t)(l * 9 + r) * 3072 + col0 + jj] = s;
      }
      __syncthreads();
    }
  }
  if (blockIdx.x == 0 && tid == 0) *(unsigned*)(p.ws + OFF_BAR) = 0u;
  const int gtid = blockIdx.x * NTHREADS + tid, gsz = gridDim.x * NTHREADS;
  u16* wsb = (u16*)(p.ws + OFF_WSB);
  for (int i = gtid; i < 2 * 4 * 128 * 128; i += gsz) wsb[i] = f2bf(p.w_s[i]);
  float* biasp = (float*)(p.ws + OFF_BIASP);
  for (int i = gtid; i < 2 * NIN; i += gsz) {
    int l = i / NIN, nd = i % NIN, ns = nd;
    if (nd >= 2560 && nd < 3584) { int w = nd & 31; ns = (nd & ~31) + ((w & 1) << 4) + (w >> 1); }
    biasp[i] = p.b_in[l * NIN + ns];
  }
  float2* rope = (float2*)(p.ws + OFF_ROPE);
  for (int i = gtid; i < 128 * 16; i += gsz) {
    int pos = i >> 4, f = i & 15;
    float inv = powf(10000.f, -(float)f / 16.f);
    float ang = (float)pos * inv;
    rope[i] = make_float2(cosf(ang), sinf(ang));
  }
}

DI void phase0b(const Params& p) {
  const float* mod = (const float*)(p.ws + OFF_MOD);
  u16* u = (u16*)(p.ws + OFF_U);
  const size_t total = (size_t)NTOK * 128;
  for (size_t idx = (size_t)blockIdx.x * NTHREADS + thr(); idx < total; idx += (size_t)gridDim.x * NTHREADS) {
    int tok = (int)(idx >> 7), d0 = (int)(idx & 127) * 8;
    int bidx = tok < T_LAT ? (tok >> 13) : 8;
    const float* src = tok < T_LAT ? p.x + (size_t)tok * 1024 + d0 : p.ctx + (size_t)(tok - T_LAT) * 1024 + d0;
    const float* mb = mod + (size_t)bidx * 3072;
    float4 a = *(const float4*)src, b = *(const float4*)(src + 4);
    float4 s0 = *(const float4*)(mb + 1024 + d0), s1 = *(const float4*)(mb + 1024 + d0 + 4);
    float4 h0 = *(const float4*)(mb + d0), h1 = *(const float4*)(mb + d0 + 4);
    uint4 o;
    o.x = pk2(a.x * (1.f + s0.x) + h0.x, a.y * (1.f + s0.y) + h0.y);
    o.y = pk2(a.z * (1.f + s0.z) + h0.z, a.w * (1.f + s0.w) + h0.w);
    o.z = pk2(b.x * (1.f + s1.x) + h1.x, b.y * (1.f + s1.y) + h1.y);
    o.w = pk2(b.z * (1.f + s1.z) + h1.z, b.w * (1.f + s1.w) + h1.w);
    *(uint4*)(u + (size_t)tok * 1024 + d0) = o;
  }
}

struct EpiP1 {
  static constexpr bool PERM = true, AFTER_DRAIN = false;
  u16* z; u16* vtl; u16* vtc; const float* biasp; const float2* rope;
  DI void operator()(const pg8::f32x4 (&acc)[2][2][4][2], const pg8::Unit& u, int wr, int wc, int fr, int fq) const {
    const int slot = u.pn >> 1;
    const int cl0 = (u.pn & 1) * 256 + wc * 32 + 8 * fq;
    const int zcol = (slot == 8 ? 7 : slot) * 512;
    pg8::f32x4 bv[2][2];
#pragma unroll
    for (int bj = 0; bj < 2; ++bj)
#pragma unroll
      for (int n = 0; n < 2; ++n) bv[bj][n] = *(const pg8::f32x4*)(biasp + slot * 512 + cl0 + bj * 128 + 4 * n);
#pragma unroll
    for (int ai = 0; ai < 2; ++ai)
#pragma unroll
      for (int m = 0; m < 4; ++m) {
        const int tok = u.pm * 256 + ai * 128 + wr * 64 + m * 16 + fr;
        const bool latent = tok < T_LAT;
#pragma unroll
        for (int bj = 0; bj < 2; ++bj) {
          const int ch = cl0 + bj * 128;
          pg8::f32x4 v0 = acc[ai][bj][m][0] + bv[bj][0], v1 = acc[ai][bj][m][1] + bv[bj][1];
          if (slot <= 1) {
#pragma unroll
            for (int j = 0; j < 4; ++j) { v0[j] = gelu_as_(v0[j]); v1[j] = gelu_as_(v1[j]); }
          } else if (slot == 2 || slot == 4 || slot == 8) {
#pragma unroll
            for (int j = 0; j < 4; ++j) { v0[j] = siluf_(v0[j]); v1[j] = siluf_(v1[j]); }
          } else if (slot == 5 || slot == 6) {
            if (latent) {
              const int sidx = ch & 63, i0 = (sidx & 31) >> 1;
              const int pos = (sidx >> 5) ? (tok & 63) : ((tok & 8191) >> 6);
              const float4 ca = *(const float4*)(rope + pos * 16 + i0), cb = *(const float4*)(rope + pos * 16 + i0 + 2);
              float t0 = v0[0] * ca.x - v0[1] * ca.y, t1 = v0[0] * ca.y + v0[1] * ca.x;
              float t2 = v0[2] * ca.z - v0[3] * ca.w, t3 = v0[2] * ca.w + v0[3] * ca.z;
              v0[0] = t0; v0[1] = t1; v0[2] = t2; v0[3] = t3;
              t0 = v1[0] * cb.x - v1[1] * cb.y; t1 = v1[0] * cb.y + v1[1] * cb.x;
              t2 = v1[2] * cb.z - v1[3] * cb.w; t3 = v1[2] * cb.w + v1[3] * cb.z;
              v1[0] = t0; v1[1] = t1; v1[2] = t2; v1[3] = t3;
            }
            if (slot == 5) { v0 *= 0.18033688011112042f; v1 *= 0.18033688011112042f; }
          }
          if (slot == 7) {
            u16* dst; int stride;
            if (latent) { dst = vtl + ((size_t)((tok >> 13) * 512 + ch) * 8192 + (tok & 8191)); stride = 8192; }
            else { const int tc = tok - T_LAT; dst = vtc + ((size_t)((tc >> 8) * 512 + ch) * 256 + (tc & 255)); stride = 256; }
#pragma unroll
            for (int j = 0; j < 4; ++j) { dst[(size_t)j * stride] = f2bf(v0[j]); dst[(size_t)(4 + j) * stride] = f2bf(v1[j]); }
          } else {
            *(uint4*)(z + (size_t)tok * ZC + zcol + ch) = make_uint4(pk2(v0[0], v0[1]), pk2(v0[2], v0[3]), pk2(v1[0], v1[1]), pk2(v1[2], v1[3]));
          }
        }
      }
  }
};

DI void phase1(const Params& p, int l, char* lds) {
  EpiP1 E;
  E.z = (u16*)(p.ws + OFF_Z); E.vtl = (u16*)(p.ws + OFF_VTL); E.vtc = (u16*)(p.ws + OFF_VTC);
  E.biasp = (const float*)(p.ws + OFF_BIASP) + l * NIN; E.rope = (const float2*)(p.ws + OFF_ROPE);
  pg8::StaticOrder S;
  S.init(NTOK, 4608, gridDim.x, blockIdx.x);
  pg8::gemm_phase<EpiP1, pg8::StaticOrder>((PG8_LAS unsigned char*)lds, (const u16*)(p.ws + OFF_U), 1024,
                                          (const u16*)(p.ws + OFF_WTIN) + (size_t)l * NIN * 1024, 1024, 1024, S, E);
}

DI void sgu_tile(const Params& p, int l, int tile, char* lds) {
  constexpr int VS = 136;
  u16* z = (u16*)(p.ws + OFF_Z) + (size_t)tile * 128 * ZC;
  u16* vaT = (u16*)lds;
  const u16* wsb = (const u16*)(p.ws + OFF_WSB) + (size_t)l * 4 * 128 * 128;
  const int tid = thr(), lane = tid & 63, wave = tid >> 6, n = lane & 31, hh = lane >> 5;
  {
    float g[8], bb[8];
#pragma unroll
    for (int e = 0; e < 8; ++e) { g[e] = p.sgu_ln_g[l * 512 + lane * 8 + e]; bb[e] = p.sgu_ln_b[l * 512 + lane * 8 + e]; }
#pragma unroll
    for (int qq = 0; qq < 16; ++qq) {
      const int q = wave * 16 + qq;
      uint4 raw = *(const uint4*)(z + (size_t)q * ZC + 512 + lane * 8);
      float xv[8] = {bflo(raw.x), bfhi(raw.x), bflo(raw.y), bfhi(raw.y), bflo(raw.z), bfhi(raw.z), bflo(raw.w), bfhi(raw.w)};
      float s = 0.f;
#pragma unroll
      for (int e = 0; e < 8; ++e) s += xv[e];
#pragma unroll
      for (int o = 32; o > 0; o >>= 1) s += __shfl_xor(s, o);
      const float mean = s * (1.f / 512.f);
      float ss = 0.f;
#pragma unroll
      for (int e = 0; e < 8; ++e) { xv[e] -= mean; ss += xv[e] * xv[e]; }
#pragma unroll
      for (int o = 32; o > 0; o >>= 1) ss += __shfl_xor(ss, o);
      const float rstd = rsqrtf(ss * (1.f / 512.f) + 1e-5f);
#pragma unroll
      for (int e = 0; e < 8; ++e)
        vaT[(lane * 8 + e) * VS + ((((q >> 3) ^ lane) & 15) << 3) + (q & 7)] = f2bf(xv[e] * rstd * g[e] + bb[e]);
    }
  }
  __syncthreads();
  const int grp = wave >> 1, chalf = wave & 1;
  f32x16 acc[2][4];
#pragma unroll
  for (int a = 0; a < 2; ++a)
#pragma unroll
    for (int b = 0; b < 4; ++b)
#pragma unroll
      for (int i = 0; i < 16; ++i) acc[a][b][i] = 0.f;
#pragma unroll 4
  for (int ks = 0; ks < 8; ++ks) {
    bf16x8 af[2], bq[4];
#pragma unroll
    for (int ci = 0; ci < 2; ++ci)
    {
      const int row = grp * 128 + chalf * 64 + ci * 32 + n;
      af[ci] = *(const bf16x8*)(vaT + row * VS + ((((ks * 2 + hh) ^ (row >> 3)) & 15) << 3));
    }
#pragma unroll
    for (int pt = 0; pt < 4; ++pt)
      bq[pt] = *(const bf16x8*)(wsb + (size_t)(grp * 128 + pt * 32 + n) * 128 + ks * 16 + hh * 8);
#pragma unroll
    for (int ci = 0; ci < 2; ++ci)
#pragma unroll
      for (int pt = 0; pt < 4; ++pt) acc[ci][pt] = MFMA(af[ci], bq[pt], acc[ci][pt]);
  }
#pragma unroll
  for (int pt = 0; pt < 4; ++pt) {
    const int tp = pt * 32 + n;
    const float bsv = p.b_s[(l * 4 + grp) * 128 + tp];
    u16* zr = z + (size_t)tp * ZC;
#pragma unroll
    for (int ci = 0; ci < 2; ++ci)
#pragma unroll
      for (int g = 0; g < 4; ++g) {
        const int c = grp * 128 + chalf * 64 + ci * 32 + 8 * g + 4 * hh;
        uint2 ua = *(const uint2*)(zr + c), sa = *(const uint2*)(zr + 1024 + c);
        uint2 o;
        o.x = pk2((acc[ci][pt][4 * g + 0] + bsv) * bflo(ua.x) * bflo(sa.x), (acc[ci][pt][4 * g + 1] + bsv) * bfhi(ua.x) * bfhi(sa.x));
        o.y = pk2((acc[ci][pt][4 * g + 2] + bsv) * bflo(ua.y) * bflo(sa.y), (acc[ci][pt][4 * g + 3] + bsv) * bfhi(ua.y) * bfhi(sa.y));
        *(uint2*)(zr + c) = o;
      }
  }
  __syncthreads();
}

template <int DIR>
DI void lru_unit(const Params& p, int l, int tile, int h, int ct, const u16* xs, u16* z, const u16* lruw, int lane) {
  constexpr int XS = 520;
  const int n = lane & 31, hh = lane >> 5;
  const int ch = h * 64 + ct * 32 + n;
  const u16* Wr = lruw + (size_t)((((l * 2 + DIR) * 2 + 0) * 8) + h) * 4096 + (ct * 32 + n) * 64;
  const u16* Wi = lruw + (size_t)((((l * 2 + DIR) * 2 + 1) * 8) + h) * 4096 + (ct * 32 + n) * 64;
  bf16x8 wr[4], wi[4];
#pragma unroll
  for (int ks = 0; ks < 4; ++ks) {
    wr[ks] = *(const bf16x8*)(Wr + ks * 16 + hh * 8);
    wi[ks] = *(const bf16x8*)(Wi + ks * 16 + hh * 8);
  }
  const int pidx = (l * 2 + DIR) * 512 + ch;
  const float ba = p.lru_ba[pidx], bx = p.lru_bx[pidx];
  const float sp = log1pf(expf(-p.lru_lam[pidx]));
  const bool first = DIR == 0 ? (hh == 0) : (hh == 1);
  float Ch = 0.f, Cp = 1.f;
#pragma unroll 1
  for (int rti = 0; rti < 4; ++rti) {
    const int rt = DIR == 0 ? rti : 3 - rti;
    u16* zc = z + (size_t)(rt * 32 + 4 * hh) * ZC + ch;
    unsigned sgr[16], oldr[16];
#pragma unroll
    for (int i = 0; i < 16; ++i)
      asm volatile("global_load_ushort %0, %1, off" : "=v"(sgr[i]) : "v"(zc + (size_t)((i & 3) + 8 * (i >> 2)) * ZC + 4 * 512) : "memory");
    if (DIR == 1) {
#pragma unroll
      for (int i = 0; i < 16; ++i)
        asm volatile("global_load_ushort %0, %1, off" : "=v"(oldr[i]) : "v"(zc + (size_t)((i & 3) + 8 * (i >> 2)) * ZC + 1 * 512) : "memory");
    }
    f32x16 A, B;
#pragma unroll
    for (int i = 0; i < 16; ++i) { A[i] = 0.f; B[i] = 0.f; }
#pragma unroll
    for (int ks = 0; ks < 4; ++ks) {
      const bf16x8 xa = *(const bf16x8*)(xs + (rt * 32 + n) * XS + h * 64 + ks * 16 + hh * 8);
      A = MFMA(xa, wr[ks], A);
      B = MFMA(xa, wi[ks], B);
    }
    const u16* xcol = xs + (rt * 32 + 4 * hh) * XS + ch;
#pragma unroll
    for (int i = 0; i < 16; ++i) {
      const float xcv = bf2f(xcol[((i & 3) + 8 * (i >> 2)) * XS]);
      const float r = sigmoidf_(A[i] + ba), ig = sigmoidf_(B[i] + bx);
      const float la = -8.f * r * sp;
      const float av = __expf(la);
      A[i] = av;
      B[i] = __builtin_amdgcn_sqrtf(fmaxf(1.f - av * av, 0.f)) * (ig * xcv);
    }
#pragma unroll
    for (int qi = 0; qi < 4; ++qi) {
      const int q = DIR == 0 ? qi : 3 - qi;
      float lp = 1.f, lh = 0.f;
#pragma unroll
      for (int ci = 0; ci < 4; ++ci) {
        const int c = DIR == 0 ? ci : 3 - ci;
        const float a = A[4 * q + c], b = B[4 * q + c];
        lh = a * lh + b; lp = lp * a;
        A[4 * q + c] = lp; B[4 * q + c] = lh;
      }
      const float pp = __shfl_xor(lp, 32), ph = __shfl_xor(lh, 32);
      const float A0 = first ? lp : pp, B0 = first ? lh : ph, A1 = first ? pp : lp, B1 = first ? ph : lh;
      const float inh = first ? Ch : (A0 * Ch + B0), inp = first ? Cp : (A0 * Cp);
#pragma unroll
      for (int c = 0; c < 4; ++c) {
        B[4 * q + c] = B[4 * q + c] + A[4 * q + c] * inh;
        A[4 * q + c] = A[4 * q + c] * inp;
      }
      Ch = A1 * (A0 * Ch + B0) + B1;
      Cp = A1 * A0 * Cp;
    }
    asm volatile("s_waitcnt vmcnt(0)" : "+v"(sgr[0]), "+v"(sgr[1]), "+v"(sgr[2]), "+v"(sgr[3]), "+v"(sgr[4]), "+v"(sgr[5]), "+v"(sgr[6]), "+v"(sgr[7]),
                 "+v"(sgr[8]), "+v"(sgr[9]), "+v"(sgr[10]), "+v"(sgr[11]), "+v"(sgr[12]), "+v"(sgr[13]), "+v"(sgr[14]), "+v"(sgr[15]) : : "memory");
    if (DIR == 1)
      asm volatile("" : "+v"(oldr[0]), "+v"(oldr[1]), "+v"(oldr[2]), "+v"(oldr[3]), "+v"(oldr[4]), "+v"(oldr[5]), "+v"(oldr[6]), "+v"(oldr[7]),
                   "+v"(oldr[8]), "+v"(oldr[9]), "+v"(oldr[10]), "+v"(oldr[11]), "+v"(oldr[12]), "+v"(oldr[13]), "+v"(oldr[14]), "+v"(oldr[15]) : : "memory");
#pragma unroll
    for (int i = 0; i < 16; ++i) {
      u16* zr = zc + (size_t)((i & 3) + 8 * (i >> 2)) * ZC;
      const float sg = __uint_as_float(sgr[i] << 16);
      if (DIR == 0) {
        zr[1 * 512] = f2bf(B[i] * sg);
        zr[2 * 512] = f2bf(A[i] * sg);
      } else {
        const float old = __uint_as_float(oldr[i] << 16);
        zr[1 * 512] = f2bf(old + B[i] * sg);
        zr[4 * 512] = f2bf(A[i] * sg);
      }
    }
  }
  if (hh == 0) {
    float* aggA = (float*)(p.ws + OFF_AGG);
    float* aggH = (float*)(p.ws + OFF_AGG + AGG_HALF);
    aggA[(size_t)(tile * 2 + DIR) * 512 + ch] = Cp;
    aggH[(size_t)(tile * 2 + DIR) * 512 + ch] = Ch;
  }
}

DI void lru_tile(const Params& p, int l, int tile, char* lds) {
  constexpr int XS = 520;
  u16* xs = (u16*)lds;
  const u16* zall = (const u16*)(p.ws + OFF_Z);
  const int tid = thr();
  int seqbase, pos0, seqlen;
  if (tile < 512) { seqbase = (tile >> 6) * 8192; pos0 = (tile & 63) * 128; seqlen = 8192; }
  else { int j = tile - 512; seqbase = T_LAT + (j >> 1) * 256; pos0 = (j & 1) * 128; seqlen = 256; }
  {
    const int c0 = (tid & 63) * 8, t0 = (tid >> 6) * 16;
    float cw[4][8], cb[8];
#pragma unroll
    for (int e = 0; e < 8; ++e) {
      cb[e] = p.conv_b[l * 512 + c0 + e];
#pragma unroll
      for (int j = 0; j < 4; ++j) cw[j][e] = p.conv_w[(l * 4 + j) * 512 + c0 + e];
    }
    float r0[8], r1[8], r2[8], r3[8];
    auto ldrow = [&](int pos, float (&r)[8]) {
      if (pos >= 0 && pos < seqlen) {
        uint4 raw = *(const uint4*)(zall + (size_t)(seqbase + pos) * ZC + 3 * 512 + c0);
        r[0] = bflo(raw.x); r[1] = bfhi(raw.x); r[2] = bflo(raw.y); r[3] = bfhi(raw.y);
        r[4] = bflo(raw.z); r[5] = bfhi(raw.z); r[6] = bflo(raw.w); r[7] = bfhi(raw.w);
      } else {
#pragma unroll
        for (int e = 0; e < 8; ++e) r[e] = 0.f;
      }
    };
    ldrow(pos0 + t0 - 2, r0);
    ldrow(pos0 + t0 - 1, r1);
    ldrow(pos0 + t0, r2);
#pragma unroll
    for (int i = 0; i < 16; ++i) {
      ldrow(pos0 + t0 + i + 1, r3);
      float o[8];
#pragma unroll
      for (int e = 0; e < 8; ++e) o[e] = cb[e] + cw[0][e] * r0[e] + cw[1][e] * r1[e] + cw[2][e] * r2[e] + cw[3][e] * r3[e];
      *(uint4*)(xs + (t0 + i) * XS + c0) = make_uint4(pk2(o[0], o[1]), pk2(o[2], o[3]), pk2(o[4], o[5]), pk2(o[6], o[7]));
#pragma unroll
      for (int e = 0; e < 8; ++e) { r0[e] = r1[e]; r1[e] = r2[e]; r2[e] = r3[e]; }
    }
  }
  __syncthreads();
  {
    const int lane = tid & 63, h = tid >> 6;
    u16* z = (u16*)(p.ws + OFF_Z) + (size_t)tile * 128 * ZC;
    const u16* lruw = (const u16*)(p.ws + OFF_LRUW);
    for (int ct = 0; ct < 2; ++ct) lru_unit<0>(p, l, tile, h, ct, xs, z, lruw, lane);
    for (int ct = 0; ct < 2; ++ct) lru_unit<1>(p, l, tile, h, ct, xs, z, lruw, lane);
  }
  __syncthreads();
}

DI void attn_item(const Params& p, int l, int item, char* lds) {
  float* rpbs = (float*)lds;
  const int tid = thr(), lane = tid & 63, h = tid >> 6, n = lane & 31, hh = lane >> 5;
  for (int i = tid; i < 8 * 15 * 128; i += NTHREADS) {
    const int hd = i >> 7, x = (i & 127) - 48;
    rpbs[i] = (x >= 0 && x < 31) ? p.rpb[(size_t)l * 8 * 465 + hd * 31 + x] * 1.4426950408889634f : 0.f;
  }
  __syncthreads();
  u16* z = (u16*)(p.ws + OFF_Z);
  const u16* vtl = (const u16*)(p.ws + OFF_VTL);
  const u16* vtc = (const u16*)(p.ws + OFF_VTC);
  const bool latent = item < 1024;
  int b, r = 0, qbase, r0 = 0;
  if (latent) { b = item >> 7; r = item & 127; qbase = b * 8192 + r * 64; r0 = min(max(r - 4, 0), 120); }
  else { int j = item - 1024; b = j >> 2; qbase = T_LAT + b * 256 + (j & 3) * 64; }
  const int nsteps = latent ? 12 : 4;
  const int sw = (n & 19) | ((n & 4) << 1) | ((n & 8) >> 1);
  const float* rp = rpbs + h * (15 * 128);
  {
    char* qlds = lds + 65536 + h * 8192 + lane * 16;
#pragma unroll
    for (int t = 0; t < 2; ++t)
#pragma unroll
      for (int ks = 0; ks < 4; ++ks)
        *(bf16x8*)(qlds + t * 4096 + ks * 1024) = *(const bf16x8*)(z + (size_t)(qbase + t * 32 + n) * ZC + 5 * 512 + h * 64 + ks * 16 + hh * 8);
    f32x16 O[2][2];
#pragma unroll
    for (int t = 0; t < 2; ++t)
#pragma unroll
      for (int i = 0; i < 16; ++i) { O[t][0][i] = 0.f; O[t][1][i] = 0.f; }
    float m[2] = {-1e30f, -1e30f}, lsum[2] = {0.f, 0.f};
    int qcs[2]; unsigned long long vmask[2];
#pragma unroll
    for (int t = 0; t < 2; ++t) { qcs[t] = t * 32 + n; const int c0 = min(max(qcs[t] - 8, 0), 48); vmask[t] = 0xFFFFull << c0; }
    bf16x8 Kc[4], Vc[4], Kn[4], Vn[4];
    auto issue = [&](int st, bf16x8 (&Kd)[4], bf16x8 (&Vd)[4]) {
      int kt0, koff, vld;
      const u16* vb;
      if (st < 8) { kt0 = T_LAT + b * 256 + st * 32; vb = vtc + (size_t)(b * 512 + h * 64) * 256; koff = st * 32; vld = 256; }
      else { const int kr = r0 + ((st - 8) >> 1), half = (st - 8) & 1; kt0 = b * 8192 + kr * 64 + half * 32;
             vb = vtl + (size_t)(b * 512 + h * 64) * 8192; koff = kr * 64 + half * 32; vld = 8192; }
      const u16* kp = z + (size_t)(kt0 + sw) * ZC + 6 * 512 + h * 64 + hh * 8;
#pragma unroll
      for (int ks = 0; ks < 4; ++ks) gload16_asm(Kd[ks], kp + ks * 16);
#pragma unroll
      for (int s2 = 0; s2 < 2; ++s2)
#pragma unroll
        for (int dt = 0; dt < 2; ++dt)
          gload16_asm(Vd[s2 * 2 + dt], vb + (size_t)(dt * 32 + n) * vld + koff + 16 * s2 + 8 * hh);
    };
    const int ns32 = nsteps * 2;
    auto step = [&](int st, bf16x8 (&Ku)[4], bf16x8 (&Vu)[4], bf16x8 (&Kp)[4], bf16x8 (&Vp)[4]) {
      if (st + 1 < ns32) issue(st + 1, Kp, Vp);
#pragma unroll
      for (int t = 0; t < 2; ++t) {
        f32x16 S;
#pragma unroll
        for (int i = 0; i < 16; ++i) S[i] = 0.f;
#pragma unroll
        for (int ks = 0; ks < 4; ++ks) S = MFMA(Ku[ks], *(const bf16x8*)(qlds + t * 4096 + ks * 1024), S);
        if (st >= 8) {
          const int kr = r0 + ((st - 8) >> 1), half = (st - 8) & 1;
          const int kbase = half * 32 + 8 * hh;
          const float* rrow = rp + (kr - r + 7) * 128 + 48 + (kbase + 15 - qcs[t]);
          const unsigned w = (unsigned)(vmask[t] >> kbase);
#pragma unroll
          for (int i = 0; i < 16; ++i) {
            const int pos = 16 * (i >> 3) + (i & 7);
            S[i] = ((w >> pos) & 1u) ? (S[i] + rrow[pos]) : -1e30f;
          }
        }
        float mt = -1e30f;
#pragma unroll
        for (int i = 0; i < 16; ++i) mt = fmaxf(mt, S[i]);
        mt = fmaxf(mt, __shfl_xor(mt, 32));
        if (__builtin_amdgcn_ballot_w64(mt > m[t] + 8.f) != 0ull) {
          const float mn = fmaxf(m[t], mt);
          const float alpha = __builtin_amdgcn_exp2f(m[t] - mn);
          m[t] = mn;
          lsum[t] *= alpha;
#pragma unroll
          for (int i = 0; i < 16; ++i) { O[t][0][i] *= alpha; O[t][1][i] *= alpha; }
        }
        float ps = 0.f;
#pragma unroll
        for (int i = 0; i < 16; ++i) { const float e = __builtin_amdgcn_exp2f(S[i] - m[t]); S[i] = e; ps += e; }
        lsum[t] += ps;
#pragma unroll
        for (int s2 = 0; s2 < 2; ++s2) {
          typedef unsigned u32x4 __attribute__((ext_vector_type(4)));
          u32x4 pw;
          pw[0] = pk2(S[8 * s2 + 0], S[8 * s2 + 1]);
          pw[1] = pk2(S[8 * s2 + 2], S[8 * s2 + 3]);
          pw[2] = pk2(S[8 * s2 + 4], S[8 * s2 + 5]);
          pw[3] = pk2(S[8 * s2 + 6], S[8 * s2 + 7]);
          const bf16x8 Pf = __builtin_bit_cast(bf16x8, pw);
#pragma unroll
          for (int dt = 0; dt < 2; ++dt) O[t][dt] = MFMA(Vu[s2 * 2 + dt], Pf, O[t][dt]);
        }
      }
      if (st + 1 < ns32) {
        vm_wait0_4(Kp[0], Kp[1], Kp[2], Kp[3]);
        vm_wait0_4(Vp[0], Vp[1], Vp[2], Vp[3]);
      }
    };
    issue(0, Kc, Vc);
    vm_wait0_4(Kc[0], Kc[1], Kc[2], Kc[3]);
    vm_wait0_4(Vc[0], Vc[1], Vc[2], Vc[3]);
    for (int st = 0; st < ns32; st += 2) {
      step(st, Kc, Vc, Kn, Vn);
      step(st + 1, Kn, Vn, Kc, Vc);
    }
#pragma unroll
    for (int t = 0; t < 2; ++t) {
      const float ltot = lsum[t] + __shfl_xor(lsum[t], 32);
      const float inv = __builtin_amdgcn_rcpf(ltot);
      u16* zr = z + (size_t)(qbase + t * 32 + n) * ZC;
#pragma unroll
      for (int dt = 0; dt < 2; ++dt)
#pragma unroll
        for (int g = 0; g < 4; ++g) {
          const int d0 = h * 64 + dt * 32 + 8 * g + 4 * hh;
          const uint2 cg2 = *(const uint2*)(zr + 7 * 512 + d0);
          uint2 o;
          o.x = pk2(O[t][dt][4 * g + 0] * inv * bflo(cg2.x), O[t][dt][4 * g + 1] * inv * bfhi(cg2.x));
          o.y = pk2(O[t][dt][4 * g + 2] * inv * bflo(cg2.y), O[t][dt][4 * g + 3] * inv * bfhi(cg2.y));
          *(uint2*)(zr + 5 * 512 + d0) = o;
        }
    }
  }
  __syncthreads();
}

DI void phase2(const Params& p, int l, char* lds) {
  const int ntile = (l == 0) ? 528 : 528;
  const int nattn = (l == 0) ? 1056 : 1024;
  for (int it = blockIdx.x; it < ntile + nattn; it += gridDim.x) {
    if (it < ntile) {
      if (it < 512 || l == 0) sgu_tile(p, l, it, lds);
      lru_tile(p, l, it, lds);
    } else {
      attn_item(p, l, it - ntile, lds);
    }
  }
}

DI void phase2b(const Params& p, int l, char* lds) {
  const float* aggA = (const float*)(p.ws + OFF_AGG);
  const float* aggH = (const float*)(p.ws + OFF_AGG + AGG_HALF);
  float* car = (float*)lds;
  const int tid = thr();
  const int ntile = (l == 0) ? 528 : 512;
  for (int tile = blockIdx.x; tile < ntile; tile += gridDim.x) {
    {
      const int ch = tid;
      float hf = 0.f, hr = 0.f;
      if (tile < 512) {
        const int b = tile >> 6, nn = tile & 63;
        for (int j = 0; j < 2; ++j) { int t = 512 + 2 * b + j; hf = aggA[(size_t)(t * 2) * 512 + ch] * hf + aggH[(size_t)(t * 2) * 512 + ch]; }
        for (int j = 0; j < nn; ++j) { int t = 64 * b + j; hf = aggA[(size_t)(t * 2) * 512 + ch] * hf + aggH[(size_t)(t * 2) * 512 + ch]; }
        for (int j = 1; j >= 0; --j) { int t = 512 + 2 * b + j; hr = aggA[(size_t)(t * 2 + 1) * 512 + ch] * hr + aggH[(size_t)(t * 2 + 1) * 512 + ch]; }
        for (int j = 63; j > nn; --j) { int t = 64 * b + j; hr = aggA[(size_t)(t * 2 + 1) * 512 + ch] * hr + aggH[(size_t)(t * 2 + 1) * 512 + ch]; }
      } else {
        const int b = (tile - 512) >> 1, nn = (tile - 512) & 1;
        if (nn == 1) { int t = 512 + 2 * b; hf = aggH[(size_t)(t * 2) * 512 + ch]; }
        else { int t = 512 + 2 * b + 1; hr = aggH[(size_t)(t * 2 + 1) * 512 + ch]; }
      }
      car[ch] = hf;
      car[512 + ch] = hr;
    }
    __syncthreads();
    {
      const int c0 = (tid & 63) * 8, t0 = (tid >> 6) * 16;
      float cf[8], cr[8];
#pragma unroll
      for (int e = 0; e < 8; ++e) { cf[e] = car[c0 + e]; cr[e] = car[512 + c0 + e]; }
      u16* z = (u16*)(p.ws + OFF_Z) + (size_t)tile * 128 * ZC;
#pragma unroll 4
      for (int i = 0; i < 16; ++i) {
        u16* zr = z + (size_t)(t0 + i) * ZC + c0;
        const uint4 yp = *(const uint4*)(zr + 512), pf = *(const uint4*)(zr + 1024), pr = *(const uint4*)(zr + 2048);
        uint4 o;
        o.x = pk2(bflo(yp.x) + bflo(pf.x) * cf[0] + bflo(pr.x) * cr[0], bfhi(yp.x) + bfhi(pf.x) * cf[1] + bfhi(pr.x) * cr[1]);
        o.y = pk2(bflo(yp.y) + bflo(pf.y) * cf[2] + bflo(pr.y) * cr[2], bfhi(yp.y) + bfhi(pf.y) * cf[3] + bfhi(pr.y) * cr[3]);
        o.z = pk2(bflo(yp.z) + bflo(pf.z) * cf[4] + bflo(pr.z) * cr[4], bfhi(yp.z) + bfhi(pf.z) * cf[5] + bfhi(pr.z) * cr[5]);
        o.w = pk2(bflo(yp.w) + bflo(pf.w) * cf[6] + bflo(pr.w) * cr[6], bfhi(yp.w) + bfhi(pf.w) * cf[7] + bfhi(pr.w) * cr[7]);
        *(uint4*)(zr + 512) = o;
      }
    }
    __syncthreads();
  }
}

struct EpiP3 {
  static constexpr bool PERM = true, AFTER_DRAIN = false;
  u16* gs;
  u16* mbuf; const float* biasg;
  DI void operator()(const pg8::f32x4 (&acc)[2][2][4][2], const pg8::SubUnit& u, int wr, int wc, int fr, int fq) const {
    asm volatile("" : "+v"(fr), "+v"(fq));
    const int cl0 = wc * 32 + 8 * fq;
    if (u.kind == 0) {
      pg8::f32x4 bv[2][2];
#pragma unroll
      for (int bj = 0; bj < 2; ++bj)
#pragma unroll
        for (int n = 0; n < 2; ++n) bv[bj][n] = *(const pg8::f32x4*)(biasg + u.nb * 1024 + u.pn * 256 + cl0 + bj * 128 + 4 * n);
#pragma unroll
      for (int ai = 0; ai < 2; ++ai)
#pragma unroll
        for (int m = 0; m < 4; ++m) {
          const int rl = ai * 128 + wr * 64 + m * 16 + fr;
#pragma unroll
          for (int bj = 0; bj < 2; ++bj) {
            const pg8::f32x4 v0 = acc[ai][bj][m][0] + bv[bj][0], v1 = acc[ai][bj][m][1] + bv[bj][1];
            *(uint4*)(gs + rl * 256 + cl0 + bj * 128) =
                make_uint4(pk2(sigmoidf_(v0[0]), sigmoidf_(v0[1])), pk2(sigmoidf_(v0[2]), sigmoidf_(v0[3])),
                           pk2(sigmoidf_(v1[0]), sigmoidf_(v1[1])), pk2(sigmoidf_(v1[2]), sigmoidf_(v1[3])));
          }
        }
    } else {
#pragma unroll
      for (int ai = 0; ai < 2; ++ai)
#pragma unroll
        for (int m = 0; m < 4; ++m) {
          const int rl = ai * 128 + wr * 64 + m * 16 + fr;
          u16* mrow = mbuf + (size_t)(u.pm * 256 + rl) * 1024 + u.pn * 256 + cl0;
#pragma unroll
          for (int bj = 0; bj < 2; ++bj) {
            const uint4 g = *(const uint4*)(gs + rl * 256 + cl0 + bj * 128);
            const pg8::f32x4 a0 = acc[ai][bj][m][0], a1 = acc[ai][bj][m][1];
            float r0 = bflo(g.x) * a0[0], r1 = bfhi(g.x) * a0[1], r2 = bflo(g.y) * a0[2], r3 = bfhi(g.y) * a0[3];
            float r4 = bflo(g.z) * a1[0], r5 = bfhi(g.z) * a1[1], r6 = bflo(g.w) * a1[2], r7 = bfhi(g.w) * a1[3];
            if (u.nb != 0) {
              const uint4 o = *(const uint4*)(mrow + bj * 128);
              r0 += bflo(o.x); r1 += bfhi(o.x); r2 += bflo(o.y); r3 += bfhi(o.y);
              r4 += bflo(o.z); r5 += bfhi(o.z); r6 += bflo(o.w); r7 += bfhi(o.w);
            }
            *(uint4*)(mrow + bj * 128) = make_uint4(pk2(r0, r1), pk2(r2, r3), pk2(r4, r5), pk2(r6, r7));
          }
        }
    }
  }
};
struct SchedP3 {
  pg8::StaticOrder tiles;
  int ctx_blk;
  const char *u, *wg, *z, *wbr;
  DI bool next(int i, pg8::SubUnit& su) const {
    const int ti = i / 6, sub = i - ti * 6;
    pg8::Unit t;
    if (ctx_blk >= 0) { if (ti > 0) return false; t.pm = 256 + (ctx_blk >> 2); t.pn = ctx_blk & 3; }
    else if (!tiles.next(ti, t)) return false;
    su.pm = t.pm; su.pn = t.pn; su.nb = sub >> 1; su.kind = sub & 1;
    if (su.kind == 0) {
      su.a = u + (size_t)t.pm * 256 * 1024 * 2;
      su.b = wg + (size_t)(su.nb * 1024 + t.pn * 256) * 1024 * 2;
    } else {
      const int slotcol = (su.nb == 0) ? 0 : (su.nb == 1 ? 512 : 5 * 512);
      su.a = z + ((size_t)t.pm * 256 * ZC + slotcol) * 2;
      su.b = wbr + (size_t)(su.nb * 1024 + t.pn * 256) * 512 * 2;
    }
    return true;
  }
};

DI void phase3(const Params& p, int l, char* lds, int mode = 0) {
  if (mode == 2 && blockIdx.x >= 32) return;
  EpiP3 E;
  E.gs = (u16*)(p.ws + OFF_GS) + (size_t)blockIdx.x * 65536;
  E.mbuf = (u16*)(p.ws + OFF_M);
  E.biasg = (const float*)(p.ws + OFF_BIASP) + l * NIN + 4608;
  SchedP3 S;
  S.tiles.init((l == 0 && mode == 0) ? NTOK : T_LAT, 1024, gridDim.x, blockIdx.x);
  S.ctx_blk = (mode == 2) ? (int)blockIdx.x : -1;
  S.u = p.ws + OFF_U;
  S.wg = p.ws + OFF_WTIN + ((size_t)l * NIN + 4608) * 1024 * 2;
  S.z = p.ws + OFF_Z;
  S.wbr = p.ws + OFF_WTBR + (size_t)l * 3 * 1024 * 512 * 2;
  pg8::Kinds kd;
  kd.lda0 = 1024; kd.ldb0 = 1024; kd.nt0 = 16;
  kd.lda1 = ZC;   kd.ldb1 = 512;  kd.nt1 = 8;
  pg8::gemm_stream2<EpiP3, SchedP3>((PG8_LAS unsigned char*)lds, kd, S, E);
}

struct EpiP4 {
  static constexpr bool PERM = false, AFTER_DRAIN = false;
  const float *x, *ctx, *mod; float *out, *rctx; int l;
  DI void operator()(const pg8::f32x4 (&acc)[2][2][4][2], const pg8::Unit& u, int wr, int wc, int fr, int fq) const {
    asm volatile("" : "+v"(fr), "+v"(fq));
    const int c0 = u.pn * 256 + wc * 32 + 4 * fq;
    const int tok0 = u.pm * 256;
    const int bidx = tok0 < T_LAT ? (tok0 >> 13) : 8;
    const float* gate = mod + (size_t)(l * 9 + bidx) * 3072 + 2048 + c0;
    pg8::f32x4 gv[2][2];
#pragma unroll
    for (int bj = 0; bj < 2; ++bj)
#pragma unroll
      for (int n = 0; n < 2; ++n) gv[bj][n] = *(const pg8::f32x4*)(gate + bj * 128 + n * 16);
#pragma unroll
    for (int ai = 0; ai < 2; ++ai)
#pragma unroll
      for (int m = 0; m < 4; ++m) {
        const int tok = tok0 + ai * 128 + wr * 64 + m * 16 + fr;
        const float* xr; float* dst;
        if (tok < T_LAT) { xr = (l == 0 ? x : out) + (size_t)tok * 1024 + c0; dst = out + (size_t)tok * 1024 + c0; }
        else { xr = ctx + (size_t)(tok - T_LAT) * 1024 + c0; dst = rctx + (size_t)(tok - T_LAT) * 1024 + c0; }
#pragma unroll
        for (int bj = 0; bj < 2; ++bj)
#pragma unroll
          for (int n = 0; n < 2; ++n) {
            const pg8::f32x4 xv = *(const pg8::f32x4*)(xr + bj * 128 + n * 16);
            *(pg8::f32x4*)(dst + bj * 128 + n * 16) = xv * ALPHA_DN + gv[bj][n] * acc[ai][bj][m][n];
          }
      }
  }
};
struct SchedP4 {
  pg8::StaticOrder so; int mode, c, G;
  DI bool next(int i, pg8::Unit& u) const {
    if (mode == 0) return so.next(i, u);
    if (mode == 2) { if (c >= 32 || i > 0) return false; u.pm = 256 + (c >> 2); u.pn = c & 3; return true; }
    int L;
    if (c < 32) { if (i > 0) return false; L = c; } else L = 32 + (c - 32) + (G - 32) * i;
    if (L >= 1024) return false;
    u.pm = (L >> 5) * 8 + (L & 7); u.pn = (L >> 3) & 3;
    return true;
  }
};
DI void phase4a(const Params& p, int l, char* lds, int mode = 0) {
  EpiP4 E;
  E.x = p.x; E.ctx = p.ctx; E.mod = (const float*)(p.ws + OFF_MOD); E.out = p.out; E.rctx = (float*)(p.ws + OFF_RCTX); E.l = l;
  SchedP4 S;
  S.so.init(l == 0 ? NTOK : T_LAT, 1024, gridDim.x, blockIdx.x);
  S.mode = mode; S.c = blockIdx.x; S.G = gridDim.x;
  pg8::gemm_phase<EpiP4, SchedP4>((PG8_LAS unsigned char*)lds, (const u16*)(p.ws + OFF_M), 1024,
                                  (const u16*)(p.ws + OFF_WTOUT) + (size_t)l * 1024 * 1024, 1024, 1024, S, E);
}
DI void phase4b(const Params& p, int l) {
  const float* mod = (const float*)(p.ws + OFF_MOD);
  float* rctx = (float*)(p.ws + OFF_RCTX);
  u16* u = (u16*)(p.ws + OFF_U);
  const int tid = thr(), lane = tid & 63, wave = tid >> 6;
  const int nrows = (l == 0) ? NTOK : T_LAT;
  float4 lg[4], lb[4];
#pragma unroll
  for (int i = 0; i < 4; ++i) { lg[i] = *(const float4*)(p.ln_g + l * 1024 + i * 256 + lane * 4); lb[i] = *(const float4*)(p.ln_b + l * 1024 + i * 256 + lane * 4); }
  for (int row = blockIdx.x * 8 + wave; row < nrows; row += gridDim.x * 8) {
    float* src = row < T_LAT ? p.out + (size_t)row * 1024 : rctx + (size_t)(row - T_LAT) * 1024;
    float4 v[4];
#pragma unroll
    for (int i = 0; i < 4; ++i) v[i] = *(const float4*)(src + i * 256 + lane * 4);
    float s = 0.f;
#pragma unroll
    for (int i = 0; i < 4; ++i) s += (v[i].x + v[i].y) + (v[i].z + v[i].w);
#pragma unroll
    for (int o = 32; o > 0; o >>= 1) s += __shfl_xor(s, o);
    const float mean = s * (1.f / 1024.f);
    float ss = 0.f;
#pragma unroll
    for (int i = 0; i < 4; ++i) { v[i].x -= mean; v[i].y -= mean; v[i].z -= mean; v[i].w -= mean; ss += (v[i].x * v[i].x + v[i].y * v[i].y) + (v[i].z * v[i].z + v[i].w * v[i].w); }
#pragma unroll
    for (int o = 32; o > 0; o >>= 1) ss += __shfl_xor(ss, o);
    const float rstd = rsqrtf(ss * (1.f / 1024.f) + 1e-5f);
    const int bidx = row < T_LAT ? (row >> 13) : 8;
    const float* m1 = mod + (size_t)(9 + bidx) * 3072;
#pragma unroll
    for (int i = 0; i < 4; ++i) {
      const int ch = i * 256 + lane * 4;
      float4 y;
      y.x = v[i].x * rstd * lg[i].x + lb[i].x; y.y = v[i].y * rstd * lg[i].y + lb[i].y;
      y.z = v[i].z * rstd * lg[i].z + lb[i].z; y.w = v[i].w * rstd * lg[i].w + lb[i].w;
      if (l == 0) {
        if (row < T_LAT) *(float4*)(p.out + (size_t)row * 1024 + ch) = y;
        const float4 sh = *(const float4*)(m1 + ch), scl = *(const float4*)(m1 + 1024 + ch);
        uint2 w;
        w.x = pk2(y.x * (1.f + scl.x) + sh.x, y.y * (1.f + scl.y) + sh.y);
        w.y = pk2(y.z * (1.f + scl.z) + sh.z, y.w * (1.f + scl.w) + sh.w);
        *(uint2*)(u + (size_t)row * 1024 + ch) = w;
      } else {
        *(float4*)(p.out + (size_t)row * 1024 + ch) = y;
      }
    }
  }
}

DI void grid_barrier(unsigned* ctr, unsigned target) {
  asm volatile("s_waitcnt vmcnt(0) lgkmcnt(0)" ::: "memory");
  __syncthreads();
  if (threadIdx.x == 0) {
    __builtin_amdgcn_fence(__ATOMIC_RELEASE, "agent");
    asm volatile("s_waitcnt vmcnt(0)" ::: "memory");
    __hip_atomic_fetch_add(ctr, 1u, __ATOMIC_RELAXED, __HIP_MEMORY_SCOPE_AGENT);
    while (__hip_atomic_load(ctr, __ATOMIC_RELAXED, __HIP_MEMORY_SCOPE_AGENT) < target) __builtin_amdgcn_s_sleep(2);
    __builtin_amdgcn_fence(__ATOMIC_ACQUIRE, "agent");
    asm volatile("s_waitcnt vmcnt(0)" ::: "memory");
  }
  __syncthreads();
}

__global__ void __launch_bounds__(NTHREADS) hybrid_fwd(Params p) {
  extern __shared__ __attribute__((aligned(16))) char lds[];
  cg::grid_group grid = cg::this_grid();
#define OPQ(q_) Params q_ = p; { size_t o_ = 0; asm volatile("" : "+s"(o_)); q_.ws = p.ws + o_; q_.out = p.out + o_; }
  { OPQ(q) phase0(q, lds); }
  grid.sync();
  unsigned* bar_ = (unsigned*)(p.ws + OFF_BAR); unsigned bt_ = 0;
#define GBAR() do { bt_ += gridDim.x; grid_barrier(bar_, bt_); } while (0)
  { OPQ(q) phase0b(q); }
  GBAR();
#define LAYER(l)                          \
  { OPQ(q) phase1(q, l, lds); }           \
  GBAR();                            \
  { OPQ(q) phase2(q, l, lds); }           \
  GBAR();                            \
  { OPQ(q) phase2b(q, l, lds); }          \
  GBAR();                            \
  if (l == 0 && gridDim.x == 256) {       \
      \
      \
    { OPQ(q) phase3(q, l, lds, 1); }      \
    GBAR();                               \
    { OPQ(q) phase3(q, l, lds, 2); }      \
    { OPQ(q) phase4a(q, l, lds, 1); }     \
    GBAR();                               \
    { OPQ(q) phase4a(q, l, lds, 2); }     \
  } else {                                \
    { OPQ(q) phase3(q, l, lds, 0); }      \
    GBAR();                               \
    { OPQ(q) phase4a(q, l, lds, 0); }     \
  }                                       \
  GBAR();                                 \
  { OPQ(q) phase4b(q, l); }
  LAYER(0)
  GBAR();
  LAYER(1)
#undef LAYER
#undef OPQ
#undef GBAR
}

extern "C" void kernel_launch(void* const* d_in, const int* in_sizes, int n_in, void* d_out, int out_size, void* d_ws,
                              size_t ws_size, hipStream_t stream) {
  static int grid_blocks = 0;
  if (!grid_blocks) {
    static const int expect[24] = {67108864, 8192, 2097152, 1024, 6291456, 6144, 15728640, 15360, 1024, 1024, 131072, 1024,
                                   4096, 1024, 131072, 2048, 131072, 2048, 2048, 7440, 3145728, 2097152, 2048, 2048};
    bool ok = (n_in == 24) && (out_size == 67108864);
    for (int i = 0; ok && i < 24; ++i) ok = (in_sizes[i] == expect[i]);
    if (!ok || ws_size < WS_END) {
      fprintf(stderr, "kernel_launch: unexpected n_in %d or ws_size %zu (< %zu)\n", n_in, ws_size, (size_t)WS_END);
      grid_blocks = -1;
      return;
    }
    int dev = 0, cus = 0, per_cu = 0;
    hipGetDevice(&dev);
    hipDeviceGetAttribute(&cus, hipDeviceAttributeMultiprocessorCount, dev);
    hipFuncSetAttribute((const void*)hybrid_fwd, hipFuncAttributeMaxDynamicSharedMemorySize, LDS_BYTES);
    hipOccupancyMaxActiveBlocksPerMultiprocessor(&per_cu, (const void*)hybrid_fwd, NTHREADS, LDS_BYTES);
    if (per_cu < 1) per_cu = 1;
    grid_blocks = cus * per_cu;
    (void)hipGetLastError();
  }
  if (grid_blocks < 0) return;
  Params p{};
  const float** pp = (const float**)&p;
  for (int i = 0; i < 24; ++i) pp[i] = (const float*)d_in[i];
  p.out = (float*)d_out;
  p.ws = (char*)d_ws;
  void* args[] = {&p};
  hipError_t e = hipLaunchCooperativeKernel((const void*)hybrid_fwd, dim3(grid_blocks), dim3(NTHREADS), args, LDS_BYTES, stream);
  if (e != hipSuccess) fprintf(stderr, "cooperative launch failed: %s (grid %d)\n", hipGetErrorString(e), grid_blocks);
}
```
